# Optimizing an MI355X kernel written in HIP

```python
import jax, jax.numpy as jnp
from jax import lax
import numpy as np

D_MODEL = 1024
BATCH = 8
SEQ = 2048
DEPTH = 2

N_MIXERS = 2
N_MLSTM_LAYERS = (DEPTH + 1) // 2
N_POOL_LAYERS = DEPTH // 2
MLSTM_HEADS = 8
MLSTM_DV = D_MODEL // MLSTM_HEADS
MLSTM_DQK = MLSTM_DV // 2
MLSTM_CHUNK = 64
GATE_SOFTCAP = 15.0
MLSTM_IN_COLS = 2 * MLSTM_HEADS * MLSTM_DQK + 2 * MLSTM_HEADS * MLSTM_DV + 4 * MLSTM_HEADS
POOL_WINDOWS = (2, 4, 8, 16)
POOL_GROUPS = len(POOL_WINDOWS)
POOL_GROUP_DIM = D_MODEL // POOL_GROUPS
D_FF = 4 * D_MODEL
EPS = 1e-6

kernel_name = 'bidir_mlstm_pool_hybrid_trunk'


def _rmsnorm(x, g):
    xf = x.astype(jnp.float32)
    y = xf * lax.rsqrt(jnp.mean(xf * xf, axis=-1, keepdims=True) + EPS)
    return (y * g.astype(jnp.float32)).astype(x.dtype)


def _mlstm_chunkwise(q, k, v, log_i, log_f):
    B, H, S, dk = q.shape
    dv = v.shape[-1]
    L = MLSTM_CHUNK
    nc = S // L

    def to_chunks(t):
        return jnp.moveaxis(t.reshape((B, H, nc, L) + t.shape[3:]), 2, 0)

    xs = tuple(to_chunks(t) for t in (q, k, v, log_i, log_f))
    lower = jnp.tril(jnp.ones((L, L), dtype=bool))

    def step(carry, inp):
        C, n, m = carry
        qj, kj, vj, ij, fj = inp
        b = jnp.cumsum(fj, axis=-1)
        d = b[..., :, None] - b[..., None, :] + ij[..., None, :]
        d = jnp.where(lower, d, -jnp.inf)
        m_inter = b + m[..., None]
        m_t = jnp.maximum(m_inter, jnp.max(d, axis=-1))
        s = jnp.einsum('bhtd,bhsd->bhts', qj, kj) * jnp.exp(d - m_t[..., None])
        sc = jnp.exp(m_inter - m_t)
        num = jnp.einsum('bhts,bhsv->bhtv', s, vj) + sc[..., None] * jnp.einsum('bhtd,bhdv->bhtv', qj, C)
        den = jnp.sum(s, axis=-1) + sc * jnp.einsum('bhtd,bhd->bht', qj, n)
        h = num / jnp.maximum(jnp.abs(den), jnp.exp(-m_t))[..., None]
        b_last = b[..., -1]
        g = b_last[..., None] - b + ij
        m_new = jnp.maximum(b_last + m, jnp.max(g, axis=-1))
        decay = jnp.exp(b_last + m - m_new)
        wk = jnp.exp(g - m_new[..., None])
        C_new = decay[..., None, None] * C + jnp.einsum('bhs,bhsd,bhsv->bhdv', wk, kj, vj)
        n_new = decay[..., None] * n + jnp.einsum('bhs,bhsd->bhd', wk, kj)
        return (C_new, n_new, m_new), h

    init = (jnp.zeros((B, H, dk, dv), jnp.float32),
            jnp.zeros((B, H, dk), jnp.float32),
            jnp.zeros((B, H), jnp.float32))
    _, hc = lax.scan(step, init, xs)
    return jnp.moveaxis(hc, 0, 2).reshape(B, H, S, dv)


def _mlstm_mixer(u, w_in, gate_b, head_g, w_out):
    B, S, _ = u.shape
    H, dk, dv = MLSTM_HEADS, MLSTM_DQK, MLSTM_DV
    proj = u @ w_in
    cuts = [H * dk, 2 * H * dk, 2 * H * dk + H * dv, 2 * H * dk + 2 * H * dv]
    q, k, v, o, gates = jnp.split(proj, cuts, axis=-1)

    def heads(t, d):
        return t.reshape(B, S, H, d).transpose(0, 2, 1, 3).astype(jnp.float32)

    q = heads(q, dk) * (dk ** -0.5)
    k = heads(k, dk)
    v = heads(v, dv)
    g = gates.astype(jnp.float32) + gate_b.astype(jnp.float32)
    g = GATE_SOFTCAP * jnp.tanh(g / GATE_SOFTCAP)
    g = g.reshape(B, S, 4, H).transpose(2, 0, 3, 1)
    h_fwd = _mlstm_chunkwise(q, k, v, g[0], jax.nn.log_sigmoid(g[1]))

    def flip(t):
        return jnp.flip(t, axis=2)

    h_bwd = flip(_mlstm_chunkwise(flip(q), flip(k), flip(v), flip(g[2]), flip(jax.nn.log_sigmoid(g[3]))))
    h = h_fwd + h_bwd
    h = h * lax.rsqrt(jnp.mean(h * h, axis=-1, keepdims=True) + EPS)
    h = h.transpose(0, 2, 1, 3).reshape(B, S, H * dv) * head_g.astype(jnp.float32)
    h = (h * jax.nn.sigmoid(o.astype(jnp.float32))).astype(u.dtype)
    return h @ w_out


def _centred_mean(a, w):
    B, S, C = a.shape
    csum = jnp.concatenate([jnp.zeros((B, 1, C), jnp.float32),
                            jnp.cumsum(a.astype(jnp.float32), axis=1)], axis=1)
    t = np.arange(S)
    lo = np.clip(t - w // 2, 0, S)
    hi = np.clip(t + w - w // 2, 0, S)
    count = (hi - lo).astype(np.float32)
    return (csum[:, hi] - csum[:, lo]) / count[None, :, None]


def _pool_mixer(u, w_in, w_group, w_out, scale):
    B, S, _ = u.shape
    a = u @ w_in
    groups = jnp.split(a, POOL_GROUPS, axis=-1)
    pooled = jnp.stack([_centred_mean(gp, w) - gp.astype(jnp.float32)
                        for gp, w in zip(groups, POOL_WINDOWS)], axis=2)
    mixed = jnp.einsum('bsgc,gcd->bsgd', pooled.astype(u.dtype), w_group).reshape(B, S, D_MODEL)
    return (mixed @ w_out) * scale


def _mlp(u, w1, w2):
    return jnp.square(jax.nn.relu(u @ w1)) @ w2


def setup_inputs(seed: int = 0) -> dict:
    key = jax.random.key(seed)
    ks = jax.random.split(key, 16)
    D = D_MODEL

    def nrm(k, shape, fan_in):
        return jax.random.normal(k, shape, jnp.float32) * (fan_in ** -0.5)

    def gain(k, shape):
        return 1.0 + 0.02 * jax.random.normal(k, shape, jnp.float32)

    x = jax.random.normal(ks[0], (BATCH, SEQ, D), jnp.float32)
    mix_norm_g = gain(ks[1], (DEPTH, D))
    mlp_norm_g = gain(ks[2], (DEPTH, D))
    mlstm_w_in = nrm(ks[3], (N_MLSTM_LAYERS, D, MLSTM_IN_COLS), D)
    f_base = jnp.linspace(3.0, 6.0, MLSTM_HEADS, dtype=jnp.float32)
    zero = jnp.zeros_like(f_base)
    base = jnp.stack([zero, f_base, zero, f_base])[None]
    mlstm_gate_b = (base + 0.1 * jax.random.normal(ks[4], (N_MLSTM_LAYERS, 4, MLSTM_HEADS), jnp.float32)
                    ).reshape(N_MLSTM_LAYERS, 4 * MLSTM_HEADS)
    mlstm_head_g = gain(ks[5], (N_MLSTM_LAYERS, MLSTM_HEADS * MLSTM_DV))
    mlstm_w_out = nrm(ks[6], (N_MLSTM_LAYERS, MLSTM_HEADS * MLSTM_DV, D), MLSTM_HEADS * MLSTM_DV)
    pool_w_in = nrm(ks[7], (N_POOL_LAYERS, D, D), D)
    pool_w_group = nrm(ks[8], (N_POOL_LAYERS, POOL_GROUPS, POOL_GROUP_DIM, POOL_GROUP_DIM), POOL_GROUP_DIM)
    pool_w_out = nrm(ks[9], (N_POOL_LAYERS, D, D), D)
    pool_scale = gain(ks[10], (N_POOL_LAYERS, D))
    mlp_w1 = nrm(ks[11], (DEPTH, D, D_FF), D)
    mlp_w2 = nrm(ks[12], (DEPTH, D_FF, D), D_FF)
    final_norm_g = gain(ks[13], (D,))
    return {'x': x, 'mix_norm_g': mix_norm_g, 'mlp_norm_g': mlp_norm_g,
            'mlstm_w_in': mlstm_w_in, 'mlstm_gate_b': mlstm_gate_b, 'mlstm_head_g': mlstm_head_g,
            'mlstm_w_out': mlstm_w_out, 'pool_w_in': pool_w_in, 'pool_w_group': pool_w_group,
            'pool_w_out': pool_w_out, 'pool_scale': pool_scale, 'mlp_w1': mlp_w1, 'mlp_w2': mlp_w2,
            'final_norm_g': final_norm_g}


def reference(x, mix_norm_g, mlp_norm_g, mlstm_w_in, mlstm_gate_b, mlstm_head_g, mlstm_w_out,
              pool_w_in, pool_w_group, pool_w_out, pool_scale, mlp_w1, mlp_w2, final_norm_g):
    for i in range(DEPTH):
        j = i // N_MIXERS
        u = _rmsnorm(x, mix_norm_g[i])
        if i % N_MIXERS == 0:
            x = x + _mlstm_mixer(u, mlstm_w_in[j], mlstm_gate_b[j], mlstm_head_g[j], mlstm_w_out[j])
        else:
            x = x + _pool_mixer(u, pool_w_in[j], pool_w_group[j], pool_w_out[j], pool_scale[j])
        u = _rmsnorm(x, mlp_norm_g[i])
        x = x + _mlp(u, mlp_w1[i], mlp_w2[i])
    return _rmsnorm(x, final_norm_g)
```

```cpp
#include <hip/hip_runtime.h>
#include <hip/hip_cooperative_groups.h>
#include <cstdio>
#include <cstdint>
namespace cg = cooperative_groups;

#define LAS __attribute__((address_space(3)))
typedef unsigned short bf16_t;
typedef short bf16x8 __attribute__((ext_vector_type(8)));
typedef float f32x4 __attribute__((ext_vector_type(4)));
typedef unsigned u32x4 __attribute__((ext_vector_type(4)));
typedef unsigned u32x2 __attribute__((ext_vector_type(2)));

constexpr int D = 1024, BATCH = 8, SEQ = 2048, M = BATCH * SEQ, NH = 8, DK = 64, DV = 128, FF = 4096;
constexpr int NIN = 3104, NQKVO = 3072;
constexpr float EPS = 1e-6f, SOFTCAP = 15.0f;

constexpr size_t MiB = 1u << 20;
constexpr size_t WS_WIN = 2 * MiB, WS_WO = 9 * MiB, WS_PIN = 11 * MiB, WS_WG = 13 * MiB, WS_PO = 14 * MiB;
constexpr size_t WS_W1 = 16 * MiB  , WS_W2 = 32 * MiB  ;
constexpr size_t WS_U = 48 * MiB;
constexpr size_t WS_BIG = 80 * MiB;
constexpr size_t WS_QKVO = WS_BIG;
constexpr size_t WS_G = WS_BIG + 96 * MiB;
constexpr size_t WS_HB = WS_BIG + 98 * MiB;
constexpr size_t WS_H1 = WS_BIG;
constexpr size_t WS_PA = WS_BIG, WS_PL = WS_BIG + 32 * MiB, WS_MX = WS_BIG + 64 * MiB;
constexpr size_t WS_END = WS_BIG + 162 * MiB;

__device__ __forceinline__ unsigned cvt_pk_bf16(float lo, float hi) { unsigned r; asm("v_cvt_pk_bf16_f32 %0, %1, %2" : "=v"(r) : "v"(lo), "v"(hi)); return r; }
__device__ __forceinline__ float bf_lo(unsigned u) { return __uint_as_float(u << 16); }
__device__ __forceinline__ float bf_hi(unsigned u) { return __uint_as_float(u & 0xffff0000u); }

namespace pg8 {
constexpr int BM = 256, BK = 64, HALF = 128, HTB = HALF * BK * 2, STAGE_BYTES = 8 * HTB, NXCD = 8, WGM = 8;
__host__ __device__ __forceinline__ int lds_byte(int r, int c) { const int st = (r >> 4) * 2 + (c >> 5), rr = r & 15, cc = c & 31, ob = rr * 64 + cc * 2; return st * 1024 + (ob ^ (((ob >> 9) & 1) << 5)); }
__host__ __device__ __forceinline__ void stage_rc(int b, int& R, int& C) { const int st = b / 1024, sb = b % 1024, swz = sb ^ (((sb >> 9) & 1) << 5); R = (st >> 1) * 16 + swz / 64; C = (st & 1) * 32 + (swz % 64) / 2; }
__host__ __device__ __forceinline__ int perm32(int rho) { const int n = rho >> 4, i = rho & 15; return 8 * (i >> 2) + 4 * n + (i & 3); }

struct Unit { int pm, pn; };
struct Gemm { const bf16_t* A; const bf16_t* Bt; int M, N, K, lda, ldb, acol; };

struct StaticOrder {
    int nM, nN, nwg, G, c;
    __host__ __device__ void init(int M_, int N_, int G_, int c_) { nM = M_ / BM; nN = N_ / BM; nwg = nM * nN; G = G_; c = c_; }
    __host__ __device__ bool next(int i, Unit& u) const {
        const long L = (long)i * G + c; if (L >= nwg) return false;
        int wgid = (int)L; { const int q = nwg / NXCD, r = nwg % NXCD, xcd = wgid % NXCD, off = wgid / NXCD; wgid = (xcd < r ? xcd * (q + 1) : r * (q + 1) + (xcd - r) * q) + off; }
        const int nig = WGM * nN, gid = wgid / nig, fm = gid * WGM, gsz = (nM - fm) < WGM ? (nM - fm) : WGM;
        u.pm = fm + ((wgid % nig) % gsz); u.pn = (wgid % nig) / gsz; return true;
    }
};

template <int ACT  > struct EpiBf16 {
    static constexpr bool PERM = true;
    bf16_t* O; int ldc; int qtiles; float qscale;
    __device__ __forceinline__ void operator()(const f32x4 (&acc)[2][2][4][2], const Unit& u, int wr, int wc, int fr, int fq) const {
        const int row0 = u.pm * BM + wr * 64 + fr; const int col0 = u.pn * BM + wc * 32 + 8 * fq;
        const float sc = (u.pn < qtiles) ? qscale : 1.f;
#pragma unroll
        for (int ai = 0; ai < 2; ++ai)
#pragma unroll
            for (int m = 0; m < 4; ++m) { bf16_t* rowp = O + (size_t)(row0 + ai * HALF + m * 16) * ldc + col0;
#pragma unroll
                for (int bj = 0; bj < 2; ++bj) { f32x4 v0 = acc[ai][bj][m][0], v1 = acc[ai][bj][m][1];
                    if (ACT == 2) {
#pragma unroll
                        for (int e = 0; e < 4; ++e) { float a = fmaxf(v0[e], 0.f); v0[e] = a * a; float b = fmaxf(v1[e], 0.f); v1[e] = b * b; } }
                    v0 = v0 * sc; v1 = v1 * sc; u32x4 w; w.x = cvt_pk_bf16(v0[0], v0[1]); w.y = cvt_pk_bf16(v0[2], v0[3]); w.z = cvt_pk_bf16(v1[0], v1[1]); w.w = cvt_pk_bf16(v1[2], v1[3]);
                    *(u32x4*)(rowp + bj * HALF) = w; } }
    }
};
struct EpiResF32 {
    static constexpr bool PERM = false;
    const float* base; float* out; int ldc; const float* cscale;
    __device__ __forceinline__ void operator()(const f32x4 (&acc)[2][2][4][2], const Unit& u, int wr, int wc, int fr, int fq) const {
        const int col0 = u.pn * BM + wc * 32 + 4 * fq;
        f32x4 cs[2][2];
#pragma unroll
        for (int bj = 0; bj < 2; ++bj)
#pragma unroll
            for (int n = 0; n < 2; ++n) cs[bj][n] = cscale ? *(const f32x4*)(cscale + col0 + bj * HALF + n * 16) : (f32x4){1.f, 1.f, 1.f, 1.f};
#pragma unroll
        for (int ai = 0; ai < 2; ++ai)
#pragma unroll
            for (int m = 0; m < 4; ++m) { const size_t off = (size_t)(u.pm * BM + ai * HALF + wr * 64 + m * 16 + fr) * ldc + col0;
#pragma unroll
                for (int bj = 0; bj < 2; ++bj)
#pragma unroll
                    for (int n = 0; n < 2; ++n) { const f32x4 bs = *(const f32x4*)(base + off + bj * HALF + n * 16); *(f32x4*)(out + off + bj * HALF + n * 16) = bs + acc[ai][bj][m][n] * cs[bj][n]; } }
    }
};

template <class Epi>
__device__ __forceinline__ void gemm_phase(LAS unsigned char* lds, const Gemm g, const StaticOrder& S, const Epi& E) {
    int tid_ = threadIdx.x; asm volatile("" : "+v"(tid_));
    const int tid = tid_, wid = __builtin_amdgcn_readfirstlane(tid >> 6), lane = tid & 63, wr = wid >> 2, wc = wid & 3, fr = lane & 15, fq = lane >> 4;
    const int nt = g.K / BK;
    unsigned voffA[2], voffB[2];
#pragma unroll
    for (int i = 0; i < 2; ++i) { int R, C; stage_rc(tid * 16 + i * 8192, R, C); const int Rb = Epi::PERM ? ((R & ~31) + perm32(R & 31)) : R;
        voffA[i] = (unsigned)(R * g.lda + C) * 2u; voffB[i] = (unsigned)(Rb * g.ldb + C) * 2u; }
    const size_t kstep = (size_t)(BK * 2);
    const size_t hstepA = (size_t)HALF * g.lda * 2, hstepB = (size_t)HALF * g.ldb * 2;
    const size_t tstepA = 2 * hstepA, tstepB = 2 * hstepB;
    const unsigned ldsw = (unsigned)wid * 1024u;
    const int aoff = lds_byte(wr * 64 + fr, fq * 8), boff = lds_byte(wc * 32 + fr, fq * 8);
#define PG8_SA(b, h) (((b) * 2 + (h)) * HTB)
#define PG8_SB(b, h) ((4 + (b) * 2 + (h)) * HTB)
#define PG8_STAGE(bufoff, gbase, voff) do { _Pragma("unroll") for (int _i = 0; _i < 2; ++_i) \
        __builtin_amdgcn_global_load_lds((const unsigned*)((const char*)(gbase) + (voff)[_i]), (LAS unsigned*)(lds + (bufoff) + ldsw + _i * 8192), 16, 0, 0); } while (0)
#define PG8_LDA(dst, b, h) do { _Pragma("unroll") for (int m = 0; m < 4; ++m) _Pragma("unroll") for (int k = 0; k < 2; ++k) dst[m][k] = *(const LAS bf16x8*)(lds + PG8_SA(b, h) + aoff + m * 2048 + k * 1024); } while (0)
#define PG8_LDB(dst, b, h) do { _Pragma("unroll") for (int n = 0; n < 2; ++n) _Pragma("unroll") for (int k = 0; k < 2; ++k) dst[n][k] = *(const LAS bf16x8*)(lds + PG8_SB(b, h) + boff + n * 2048 + k * 1024); } while (0)
#define PG8_MMA(ai, bj, At, Bt) do { __builtin_amdgcn_s_setprio(1); _Pragma("unroll") for (int m = 0; m < 4; ++m) _Pragma("unroll") for (int n = 0; n < 2; ++n) _Pragma("unroll") for (int k = 0; k < 2; ++k) \
        acc[ai][bj][m][n] = __builtin_amdgcn_mfma_f32_16x16x32_bf16(Bt[n][k], At[m][k], acc[ai][bj][m][n], 0, 0, 0); __builtin_amdgcn_s_setprio(0); } while (0)
#define PG8_WAIT_V(n) asm volatile("s_waitcnt vmcnt(" #n ")" ::: "memory")
#define PG8_WAIT_L(n) asm volatile("s_waitcnt lgkmcnt(" #n ")" ::: "memory")
#define PG8_BAR __builtin_amdgcn_s_barrier()
#define PG8_SCHED __builtin_amdgcn_sched_barrier(0)
    Unit cur, nxt; int ui = 0;
    if (!S.next(0, cur)) return;
    f32x4 acc[2][2][4][2];
#pragma unroll
    for (int a = 0; a < 2; ++a)
#pragma unroll
        for (int b = 0; b < 2; ++b)
#pragma unroll
            for (int m = 0; m < 4; ++m)
#pragma unroll
                for (int n = 0; n < 2; ++n) acc[a][b][m][n] = (f32x4){0.f, 0.f, 0.f, 0.f};
    bf16x8 At[4][2], B0[2][2], B1[2][2];
    const char* cA = (const char*)g.A + (size_t)cur.pm * tstepA + (size_t)cur.pn * g.acol * 2; const char* cB = (const char*)g.Bt + (size_t)cur.pn * tstepB;
    PG8_STAGE(PG8_SB(0, 0), cB, voffB); PG8_STAGE(PG8_SB(0, 1), cB + hstepB, voffB); PG8_STAGE(PG8_SA(0, 0), cA, voffA); PG8_STAGE(PG8_SA(0, 1), cA + hstepA, voffA);
    if (wr == 1) PG8_BAR;
    PG8_WAIT_V(2); PG8_BAR;
    PG8_STAGE(PG8_SB(1, 0), cB + kstep, voffB); PG8_STAGE(PG8_SA(1, 0), cA + kstep, voffA); PG8_STAGE(PG8_SB(1, 1), cB + hstepB + kstep, voffB);
    PG8_WAIT_V(6); PG8_BAR;
    for (;;) {
        const bool has_next = S.next(ui + 1, nxt);
        const char* nA = has_next ? (const char*)g.A + (size_t)nxt.pm * tstepA + (size_t)nxt.pn * g.acol * 2 : cA; const char* nB = has_next ? (const char*)g.Bt + (size_t)nxt.pn * tstepB : cB;
        for (int t = 0; t < nt; t += 2) {
            const bool last = (t == nt - 2);
            const char* a1 = cA + (size_t)(t + 1) * kstep;
            const char* a2 = last ? nA : cA + (size_t)(t + 2) * kstep; const char* b2 = last ? nB : cB + (size_t)(t + 2) * kstep;
            const char* a3 = a2 + kstep; const char* b3 = b2 + kstep;
            PG8_LDB(B0, 0, 0); PG8_LDB(B1, 0, 1); PG8_SCHED; PG8_LDA(At, 0, 0); PG8_STAGE(PG8_SA(1, 1), a1 + hstepA, voffA);
            PG8_WAIT_V(8); PG8_WAIT_L(0); PG8_BAR; PG8_MMA(0, 0, At, B0); PG8_MMA(0, 1, At, B1); PG8_BAR; PG8_SCHED;
            PG8_LDA(At, 0, 1); PG8_STAGE(PG8_SB(0, 0), b2, voffB); PG8_STAGE(PG8_SB(0, 1), b2 + hstepB, voffB); PG8_STAGE(PG8_SA(0, 0), a2, voffA);
            PG8_WAIT_V(8); PG8_WAIT_L(0); PG8_BAR; PG8_MMA(1, 0, At, B0); PG8_MMA(1, 1, At, B1); PG8_BAR; PG8_SCHED;
            PG8_LDB(B0, 1, 0); PG8_LDB(B1, 1, 1); PG8_SCHED; PG8_LDA(At, 1, 0); PG8_STAGE(PG8_SA(0, 1), a2 + hstepA, voffA);
            PG8_WAIT_V(8); PG8_WAIT_L(0); PG8_BAR; PG8_MMA(0, 0, At, B0); PG8_MMA(0, 1, At, B1); PG8_BAR; PG8_SCHED;
            PG8_LDA(At, 1, 1); PG8_STAGE(PG8_SB(1, 0), b3, voffB); PG8_STAGE(PG8_SB(1, 1), b3 + hstepB, voffB); PG8_STAGE(PG8_SA(1, 0), a3, voffA);
            PG8_WAIT_V(8); PG8_WAIT_L(0); PG8_BAR; PG8_MMA(1, 0, At, B0); PG8_MMA(1, 1, At, B1); PG8_BAR; PG8_SCHED;
        }
        if (wr == 0) PG8_BAR;
        E(acc, cur, wr, wc, fr, fq);
        if (!has_next) break;
#pragma unroll
        for (int a = 0; a < 2; ++a)
#pragma unroll
            for (int b = 0; b < 2; ++b)
#pragma unroll
                for (int m = 0; m < 4; ++m)
#pragma unroll
                    for (int n = 0; n < 2; ++n) acc[a][b][m][n] = (f32x4){0.f, 0.f, 0.f, 0.f};
        cur = nxt; cA = nA; cB = nB; ++ui;
        if (wr == 1) PG8_BAR;
    }
    PG8_WAIT_V(0);
    PG8_BAR;
#undef PG8_SA
#undef PG8_SB
#undef PG8_STAGE
#undef PG8_LDA
#undef PG8_LDB
#undef PG8_MMA
#undef PG8_WAIT_V
#undef PG8_WAIT_L
#undef PG8_BAR
#undef PG8_SCHED
}
}

__device__ __forceinline__ float wave_sum(float v) {
#pragma unroll
    for (int o = 1; o < 64; o <<= 1) v += __shfl_xor(v, o);
    return v;
}
__device__ __forceinline__ float wave_incl_sum(float v, int lane) {
#pragma unroll
    for (int o = 1; o < 64; o <<= 1) { const float t = __shfl_up(v, o); if (lane >= o) v += t; }
    return v;
}
__device__ __forceinline__ float wave_incl_max(float v, int lane) {
#pragma unroll
    for (int o = 1; o < 64; o <<= 1) { const float t = __shfl_up(v, o); if (lane >= o) v = fmaxf(v, t); }
    return v;
}

__device__ __forceinline__ void transpose_item(const float* W, int K, int N, bf16_t* WT, LAS float* scr, int item, int lane) {
    const int nblk = N / 32, kb = item / nblk, nb = item % nblk, k0 = 64 * kb, n0 = 32 * nb;
#pragma unroll 8
    for (int i = 0; i < 32; ++i) { const int kk = 2 * i + (lane >> 5); scr[kk * 33 + (lane & 31)] = W[(size_t)(k0 + kk) * N + n0 + (lane & 31)]; }
    asm volatile("s_waitcnt lgkmcnt(0)" ::: "memory");
    const int c = lane & 7;
#pragma unroll
    for (int j = 0; j < 4; ++j) { const int n = (lane >> 3) + 8 * j; const LAS float* s = scr + (8 * c) * 33 + n;
        u32x4 o; o.x = cvt_pk_bf16(s[0 * 33], s[1 * 33]); o.y = cvt_pk_bf16(s[2 * 33], s[3 * 33]); o.z = cvt_pk_bf16(s[4 * 33], s[5 * 33]); o.w = cvt_pk_bf16(s[6 * 33], s[7 * 33]);
        *(u32x4*)(WT + (size_t)(n0 + n) * K + k0 + 8 * c) = o; }
    asm volatile("s_waitcnt lgkmcnt(0)" ::: "memory");
}

__device__ __forceinline__ void rms_row_bf16(const float* xrow, const float* g, bf16_t* orow, int lane) {
    const f32x4* xr = (const f32x4*)xrow + lane; const f32x4* gr = (const f32x4*)g + lane;
    f32x4 v[4]; float s = 0.f;
#pragma unroll
    for (int j = 0; j < 4; ++j) { v[j] = xr[64 * j]; s += (v[j].x * v[j].x + v[j].y * v[j].y) + (v[j].z * v[j].z + v[j].w * v[j].w); }
    const float r = 1.0f / sqrtf(wave_sum(s) * (1.f / D) + EPS);
    u32x2* o8 = (u32x2*)orow + lane;
#pragma unroll
    for (int j = 0; j < 4; ++j) { const f32x4 gg = gr[64 * j]; u32x2 w; w.x = cvt_pk_bf16(v[j].x * r * gg.x, v[j].y * r * gg.y); w.y = cvt_pk_bf16(v[j].z * r * gg.z, v[j].w * r * gg.w); o8[64 * j] = w; }
}
__device__ __forceinline__ void rms_row_f32(const float* xrow, const float* g, float* orow, int lane) {
    const f32x4* xr = (const f32x4*)xrow + lane; const f32x4* gr = (const f32x4*)g + lane;
    f32x4 v[4]; float s = 0.f;
#pragma unroll
    for (int j = 0; j < 4; ++j) { v[j] = xr[64 * j]; s += (v[j].x * v[j].x + v[j].y * v[j].y) + (v[j].z * v[j].z + v[j].w * v[j].w); }
    const float r = 1.0f / sqrtf(wave_sum(s) * (1.f / D) + EPS);
    f32x4* o = (f32x4*)orow + lane;
#pragma unroll
    for (int j = 0; j < 4; ++j) { const f32x4 gg = gr[64 * j]; o[64 * j] = v[j] * r * gg; }
}

constexpr int LS = 72;
constexpr int ML_Q = 0, ML_K = 9216, ML_KWT = 18432, ML_VT = 27648, ML_CT = 39168, ML_END = 50688;

__device__ __forceinline__ void mlstm_phase(LAS unsigned char* lds, const bf16_t* QKVO, const float* Gt, float* HF, float* HB, int tid, int lane, int wave) {
    const int fr = lane & 15, fq = lane >> 4, tt = wave & 3, vs = wave >> 2;
    LAS bf16_t* Qs = (LAS bf16_t*)(lds + ML_Q); LAS bf16_t* Ks = (LAS bf16_t*)(lds + ML_K); LAS bf16_t* KwT = (LAS bf16_t*)(lds + ML_KWT);
    LAS bf16_t* VT = (LAS bf16_t*)(lds + ML_VT); LAS bf16_t* CT = (LAS bf16_t*)(lds + ML_CT);
    for (int item = blockIdx.x; item < 256; item += gridDim.x) {
        const int vh = item & 1, dir = (item >> 1) & 1, h = (item >> 2) & 7, b = item >> 5;
        const bf16_t* qb = QKVO + (size_t)b * SEQ * NQKVO + h * DK + 8 * wave;
        const bf16_t* kb = qb + 512;
        const bf16_t* vb = QKVO + (size_t)b * SEQ * NQKVO + 1024 + h * DV + vh * 64 + 8 * wave;
        const float* gi = Gt + (size_t)b * SEQ * 32 + (2 * dir) * 8 + h; const float* gf = gi + 8;
        float* Hout = (dir ? HB : HF) + (size_t)b * SEQ * D + h * DV + vh * 64;
        __syncthreads();
        for (int idx = tid; idx < 16 * 64; idx += 512) { const int r = 64 + (idx >> 6), c = idx & 63; VT[r * LS + c] = (r == 64) ? (bf16_t)0x3F80 : (bf16_t)0; }
        f32x4 accC[3];
#pragma unroll
        for (int i = 0; i < 3; ++i) accC[i] = (f32x4){0.f, 0.f, 0.f, 0.f};
        float m = 0.f;
        int pos = dir ? (SEQ - 1 - lane) : lane;
        u32x4 q16 = *(const u32x4*)(qb + (size_t)pos * NQKVO), k16 = *(const u32x4*)(kb + (size_t)pos * NQKVO), v16 = *(const u32x4*)(vb + (size_t)pos * NQKVO);
        float li = gi[(size_t)pos * 32], lf = gf[(size_t)pos * 32];
        for (int j = 0; j < SEQ / 64; ++j) {
            const float bcs = wave_incl_sum(lf, lane);
            const float a = li - bcs;
            const float cm = wave_incl_max(a, lane);
            const float Mv = fmaxf(m, cm);
            const float b_last = __shfl(bcs, 63), M63 = __shfl(Mv, 63);
            const float decay = __expf(m - M63);
            const float wk = __expf(a - M63);
            *(LAS u32x4*)(Qs + lane * LS + 8 * wave) = q16;
            *(LAS u32x4*)(Ks + lane * LS + 8 * wave) = k16;
            {
                const unsigned kk[4] = {k16.x, k16.y, k16.z, k16.w}, vv[4] = {v16.x, v16.y, v16.z, v16.w};
#pragma unroll
                for (int e = 0; e < 4; ++e) {
                    const unsigned kw = cvt_pk_bf16(bf_lo(kk[e]) * wk, bf_hi(kk[e]) * wk);
                    KwT[(8 * wave + 2 * e) * LS + lane] = (bf16_t)(kw & 0xffffu); KwT[(8 * wave + 2 * e + 1) * LS + lane] = (bf16_t)(kw >> 16);
                    VT[(8 * wave + 2 * e) * LS + lane] = (bf16_t)(vv[e] & 0xffffu); VT[(8 * wave + 2 * e + 1) * LS + lane] = (bf16_t)(vv[e] >> 16);
                }
            }
            {
                const int nvt = vs ? 2 : 3, vt0 = vs ? 3 : 0;
#pragma unroll
                for (int vi = 0; vi < 3; ++vi) if (vi < nvt) {
                    u32x2 w; w.x = cvt_pk_bf16(accC[vi][0], accC[vi][1]); w.y = cvt_pk_bf16(accC[vi][2], accC[vi][3]);
                    *(LAS u32x2*)(CT + (16 * (vt0 + vi) + fr) * LS + 16 * tt + 4 * fq) = w; }
            }
            __syncthreads();
            u32x4 q16n = q16, k16n = k16, v16n = v16; float lin = li, lfn = lf;
            if (j + 1 < SEQ / 64) {
                const int pn = dir ? (SEQ - 1 - (64 * (j + 1) + lane)) : (64 * (j + 1) + lane);
                q16n = *(const u32x4*)(qb + (size_t)pn * NQKVO); k16n = *(const u32x4*)(kb + (size_t)pn * NQKVO); v16n = *(const u32x4*)(vb + (size_t)pn * NQKVO);
                lin = gi[(size_t)pn * 32]; lfn = gf[(size_t)pn * 32];
            }
            bf16x8 qf[2];
            qf[0] = *(const LAS bf16x8*)(Qs + (16 * tt + fr) * LS + 8 * fq); qf[1] = *(const LAS bf16x8*)(Qs + (16 * tt + fr) * LS + 32 + 8 * fq);
            const float Mt = __shfl(Mv, 16 * tt + fr), bt = __shfl(bcs, 16 * tt + fr);
            float p[4][4];
#pragma unroll
            for (int st = 0; st < 4; ++st) {
                f32x4 s4 = (f32x4){0.f, 0.f, 0.f, 0.f};
                if (st <= tt) {
                    const bf16x8 kf0 = *(const LAS bf16x8*)(Ks + (16 * st + fr) * LS + 8 * fq), kf1 = *(const LAS bf16x8*)(Ks + (16 * st + fr) * LS + 32 + 8 * fq);
                    s4 = __builtin_amdgcn_mfma_f32_16x16x32_bf16(kf0, qf[0], s4, 0, 0, 0);
                    s4 = __builtin_amdgcn_mfma_f32_16x16x32_bf16(kf1, qf[1], s4, 0, 0, 0);
                }
#pragma unroll
                for (int i = 0; i < 4; ++i) {
                    const int sidx = 16 * st + 4 * fq + i;
                    const float as = __shfl(a, sidx);
                    const float w = (sidx <= 16 * tt + fr) ? __expf(as - Mt) : 0.f;
                    p[st][i] = s4[i] * w;
                }
            }
            bf16x8 pb[2];
#pragma unroll
            for (int kk2 = 0; kk2 < 2; ++kk2) {
                u32x4 w; w.x = cvt_pk_bf16(p[2 * kk2][0], p[2 * kk2][1]); w.y = cvt_pk_bf16(p[2 * kk2][2], p[2 * kk2][3]);
                w.z = cvt_pk_bf16(p[2 * kk2 + 1][0], p[2 * kk2 + 1][1]); w.w = cvt_pk_bf16(p[2 * kk2 + 1][2], p[2 * kk2 + 1][3]);
                pb[kk2] = __builtin_bit_cast(bf16x8, w);
            }
            const float sc = __expf(m - Mt);
            f32x4 num[3];
#pragma unroll
            for (int vi = 0; vi < 3; ++vi) {
                const int vt = (vi < 2) ? (2 * vs + vi) : 4;
                f32x4 a1 = (f32x4){0.f, 0.f, 0.f, 0.f}, a2 = (f32x4){0.f, 0.f, 0.f, 0.f};
#pragma unroll
                for (int kk2 = 0; kk2 < 2; ++kk2) {
                    const u32x2 lo = *(const LAS u32x2*)(VT + (16 * vt + fr) * LS + 32 * kk2 + 4 * fq), hi = *(const LAS u32x2*)(VT + (16 * vt + fr) * LS + 32 * kk2 + 16 + 4 * fq);
                    const u32x4 vv = (u32x4){lo.x, lo.y, hi.x, hi.y};
                    a1 = __builtin_amdgcn_mfma_f32_16x16x32_bf16(__builtin_bit_cast(bf16x8, vv), pb[kk2], a1, 0, 0, 0);
                    const bf16x8 cf = *(const LAS bf16x8*)(CT + (16 * vt + fr) * LS + 32 * kk2 + 8 * fq);
                    a2 = __builtin_amdgcn_mfma_f32_16x16x32_bf16(cf, qf[kk2], a2, 0, 0, 0);
                }
                num[vi] = a1 + a2 * sc;
            }
            const float den = __shfl(num[2][0], fr);
            const float inv = 1.0f / fmaxf(fabsf(den), __expf(-(bt + Mt)));
            {
                const int tl = 64 * j + 16 * tt + fr; const int post = dir ? (SEQ - 1 - tl) : tl;
#pragma unroll
                for (int vi = 0; vi < 2; ++vi) *(f32x4*)(Hout + (size_t)post * D + 16 * (2 * vs + vi) + 4 * fq) = num[vi] * inv;
            }
            {
                const int nvt = vs ? 2 : 3, vt0 = vs ? 3 : 0;
                const bf16x8 kf0 = *(const LAS bf16x8*)(KwT + (16 * tt + fr) * LS + 8 * fq), kf1 = *(const LAS bf16x8*)(KwT + (16 * tt + fr) * LS + 32 + 8 * fq);
#pragma unroll
                for (int vi = 0; vi < 3; ++vi) if (vi < nvt) {
                    const bf16x8 vf0 = *(const LAS bf16x8*)(VT + (16 * (vt0 + vi) + fr) * LS + 8 * fq), vf1 = *(const LAS bf16x8*)(VT + (16 * (vt0 + vi) + fr) * LS + 32 + 8 * fq);
                    f32x4 c = accC[vi] * decay;
                    c = __builtin_amdgcn_mfma_f32_16x16x32_bf16(kf0, vf0, c, 0, 0, 0);
                    c = __builtin_amdgcn_mfma_f32_16x16x32_bf16(kf1, vf1, c, 0, 0, 0);
                    accC[vi] = c; }
            }
            m = b_last + M63;
            __syncthreads();
            q16 = q16n; k16 = k16n; v16 = v16n; li = lin; lf = lfn;
        }
    }
}

struct Params {
    const float* x; const float* mix_g; const float* mlp_g; const float* w_in; const float* gate_b; const float* head_g; const float* w_out;
    const float* pw_in; const float* pw_group; const float* pw_out; const float* p_scale; const float* w1; const float* w2; const float* fin_g;
    float* out; unsigned char* ws;
};
constexpr int LDS_BYTES = 147456;

__global__ void __launch_bounds__(512, 2) fwd_kernel(Params p) {
    extern __shared__ __attribute__((aligned(16))) unsigned char lds_raw[];
    LAS unsigned char* lds = (LAS unsigned char*)lds_raw;
    cg::grid_group grid = cg::this_grid();
    const int tid = threadIdx.x, lane = tid & 63, wave = __builtin_amdgcn_readfirstlane(tid >> 6);
    const int G = gridDim.x, gw = blockIdx.x * 8 + wave, NGW = G * 8;
    unsigned char* ws = p.ws;
    bf16_t* WinT = (bf16_t*)(ws + WS_WIN); bf16_t* WoT = (bf16_t*)(ws + WS_WO); bf16_t* PinT = (bf16_t*)(ws + WS_PIN); bf16_t* WgT = (bf16_t*)(ws + WS_WG); bf16_t* PoT = (bf16_t*)(ws + WS_PO);
    bf16_t* W1T = (bf16_t*)(ws + WS_W1); bf16_t* W2T = (bf16_t*)(ws + WS_W2);
    bf16_t* U = (bf16_t*)(ws + WS_U); bf16_t* QKVO = (bf16_t*)(ws + WS_QKVO); float* Gt = (float*)(ws + WS_G); float* HB = (float*)(ws + WS_HB); float* HF = p.out;
    bf16_t* H1 = (bf16_t*)(ws + WS_H1); bf16_t* PA = (bf16_t*)(ws + WS_PA); bf16_t* PL = (bf16_t*)(ws + WS_PL); bf16_t* MX = (bf16_t*)(ws + WS_MX);
    float* XR = p.out;

    {
        LAS float* scr = (LAS float*)(lds + wave * 16384);
        constexpr int I_IN = (D / 64) * (NIN / 32), I_SQ = (D / 64) * (D / 32), I_G = (256 / 64) * (256 / 32), I_1 = (D / 64) * (FF / 32), I_2 = (FF / 64) * (D / 32);
        constexpr int NITEMS = I_IN + 3 * I_SQ + 4 * I_G + 2 * I_1 + 2 * I_2;
        for (int it = gw; it < NITEMS; it += NGW) {
            int r = it;
            if (r < I_IN) { transpose_item(p.w_in, D, NIN, WinT, scr, r, lane); continue; } r -= I_IN;
            if (r < I_SQ) { transpose_item(p.w_out, D, D, WoT, scr, r, lane); continue; } r -= I_SQ;
            if (r < I_SQ) { transpose_item(p.pw_in, D, D, PinT, scr, r, lane); continue; } r -= I_SQ;
            if (r < I_SQ) { transpose_item(p.pw_out, D, D, PoT, scr, r, lane); continue; } r -= I_SQ;
            if (r < 4 * I_G) { const int g = r / I_G; transpose_item(p.pw_group + (size_t)g * 65536, 256, 256, WgT + (size_t)g * 65536, scr, r % I_G, lane); continue; } r -= 4 * I_G;
            if (r < 2 * I_1) { const int l = r / I_1; transpose_item(p.w1 + (size_t)l * D * FF, D, FF, W1T + (size_t)l * D * FF, scr, r % I_1, lane); continue; } r -= 2 * I_1;
            { const int l = r / I_2; transpose_item(p.w2 + (size_t)l * D * FF, FF, D, W2T + (size_t)l * D * FF, scr, r % I_2, lane); }
        }
        for (int mrow = gw; mrow < M; mrow += NGW) rms_row_bf16(p.x + (size_t)mrow * D, p.mix_g, U + (size_t)mrow * D, lane);
    }
    grid.sync();

    {
        pg8::Gemm g{U, WinT, M, NQKVO, D, D, D, 0}; pg8::StaticOrder S; S.init(M, NQKVO, G, (int)blockIdx.x);
        pg8::EpiBf16<0> E{QKVO, NQKVO, 2, 0.125f};
        pg8::gemm_phase(lds, g, S, E);
        const int fr = lane & 15, fq = lane >> 4;
        for (int job = gw; job < M / 16; job += NGW) {
            const int tok0 = job * 16;
            const bf16_t* ap0 = WinT + (size_t)(NQKVO + fr) * D + 8 * fq; const bf16_t* ap1 = ap0 + 16 * D; const bf16_t* bp = U + (size_t)(tok0 + fr) * D + 8 * fq;
            f32x4 acc0 = (f32x4){0.f, 0.f, 0.f, 0.f}, acc1 = (f32x4){0.f, 0.f, 0.f, 0.f};
#pragma unroll 4
            for (int ks = 0; ks < D / 32; ++ks) {
                const bf16x8 a0 = *(const bf16x8*)(ap0 + 32 * ks), a1 = *(const bf16x8*)(ap1 + 32 * ks), bb = *(const bf16x8*)(bp + 32 * ks);
                acc0 = __builtin_amdgcn_mfma_f32_16x16x32_bf16(a0, bb, acc0, 0, 0, 0);
                acc1 = __builtin_amdgcn_mfma_f32_16x16x32_bf16(a1, bb, acc1, 0, 0, 0);
            }
#pragma unroll
            for (int nt = 0; nt < 2; ++nt) {
                const int n0 = 16 * nt + 4 * fq; const f32x4 bias = *(const f32x4*)(p.gate_b + n0);
                f32x4 gv = (nt ? acc1 : acc0) + bias;
                const bool isf = ((n0 >> 3) & 1) != 0;
#pragma unroll
                for (int e = 0; e < 4; ++e) { float t = SOFTCAP * tanhf(gv[e] * (1.0f / SOFTCAP)); if (isf) t = fminf(t, 0.f) - log1pf(expf(-fabsf(t))); gv[e] = t; }
                *(f32x4*)(Gt + (size_t)(tok0 + fr) * 32 + n0) = gv;
            }
        }
    }
    grid.sync();

    mlstm_phase(lds, QKVO, Gt, HF, HB, tid, lane, wave);
    grid.sync();

    for (int row = gw; row < M; row += NGW) {
#pragma unroll
        for (int jj = 0; jj < 4; ++jj) {
            const int c = 4 * lane + 256 * jj;
            const f32x4 hf = *(const f32x4*)(HF + (size_t)row * D + c), hb = *(const f32x4*)(HB + (size_t)row * D + c);
            const f32x4 hh = hf + hb;
            float ss = (hh.x * hh.x + hh.y * hh.y) + (hh.z * hh.z + hh.w * hh.w);
#pragma unroll
            for (int o = 1; o < 32; o <<= 1) ss += __shfl_xor(ss, o);
            const float r = 1.0f / sqrtf(ss * (1.f / DV) + EPS);
            const u32x2 ov = *(const u32x2*)(QKVO + (size_t)row * NQKVO + 2048 + c);
            const f32x4 hg = *(const f32x4*)(p.head_g + c);
            const float o0 = bf_lo(ov.x), o1 = bf_hi(ov.x), o2 = bf_lo(ov.y), o3 = bf_hi(ov.y);
            const float y0 = hh.x * r * hg.x / (1.f + __expf(-o0)), y1 = hh.y * r * hg.y / (1.f + __expf(-o1));
            const float y2 = hh.z * r * hg.z / (1.f + __expf(-o2)), y3 = hh.w * r * hg.w / (1.f + __expf(-o3));
            u32x2 w; w.x = cvt_pk_bf16(y0, y1); w.y = cvt_pk_bf16(y2, y3);
            *(u32x2*)(U + (size_t)row * D + c) = w;
        }
    }
    grid.sync();

    {
        pg8::Gemm g{U, WoT, M, D, D, D, D, 0}; pg8::StaticOrder S; S.init(M, D, G, (int)blockIdx.x);
        pg8::EpiResF32 E{p.x, XR, D, nullptr};
        pg8::gemm_phase(lds, g, S, E);
    }
    grid.sync();

    for (int layer = 0; layer < 2; ++layer) {
        if (layer == 1) {
            for (int mrow = gw; mrow < M; mrow += NGW) rms_row_bf16(XR + (size_t)mrow * D, p.mix_g + D, U + (size_t)mrow * D, lane);
            grid.sync();
            {
                pg8::Gemm g{U, PinT, M, D, D, D, D, 0}; pg8::StaticOrder S; S.init(M, D, G, (int)blockIdx.x);
                pg8::EpiBf16<0> E{PA, D, 0, 1.f};
                pg8::gemm_phase(lds, g, S, E);
            }
            grid.sync();
            for (int task = blockIdx.x * 512 + tid; task < M * 128; task += G * 512) {
                const int row = task >> 7, cgp = task & 127, gidx = cgp >> 5, w = 2 << gidx, t = row & (SEQ - 1), rb = row - t;
                const int lo = max(t - (w >> 1), 0), hi = min(t + w - (w >> 1), SEQ);
                float s[8];
#pragma unroll
                for (int e = 0; e < 8; ++e) s[e] = 0.f;
                for (int r = lo; r < hi; ++r) {
                    const u32x4 v = *(const u32x4*)(PA + (size_t)(rb + r) * D + 8 * cgp);
                    s[0] += bf_lo(v.x); s[1] += bf_hi(v.x); s[2] += bf_lo(v.y); s[3] += bf_hi(v.y); s[4] += bf_lo(v.z); s[5] += bf_hi(v.z); s[6] += bf_lo(v.w); s[7] += bf_hi(v.w);
                }
                const float ic = 1.0f / (float)(hi - lo);
                const u32x4 v = *(const u32x4*)(PA + (size_t)row * D + 8 * cgp);
                u32x4 o;
                o.x = cvt_pk_bf16(s[0] * ic - bf_lo(v.x), s[1] * ic - bf_hi(v.x)); o.y = cvt_pk_bf16(s[2] * ic - bf_lo(v.y), s[3] * ic - bf_hi(v.y));
                o.z = cvt_pk_bf16(s[4] * ic - bf_lo(v.z), s[5] * ic - bf_hi(v.z)); o.w = cvt_pk_bf16(s[6] * ic - bf_lo(v.w), s[7] * ic - bf_hi(v.w));
                *(u32x4*)(PL + (size_t)row * D + 8 * cgp) = o;
            }
            grid.sync();
            {
                pg8::Gemm g{PL, WgT, M, D, 256, D, 256, 256}; pg8::StaticOrder S; S.init(M, D, G, (int)blockIdx.x);
                pg8::EpiBf16<0> E{MX, D, 0, 1.f};
                pg8::gemm_phase(lds, g, S, E);
            }
            grid.sync();
            {
                pg8::Gemm g{MX, PoT, M, D, D, D, D, 0}; pg8::StaticOrder S; S.init(M, D, G, (int)blockIdx.x);
                pg8::EpiResF32 E{XR, XR, D, p.p_scale};
                pg8::gemm_phase(lds, g, S, E);
            }
            grid.sync();
        }
        for (int mrow = gw; mrow < M; mrow += NGW) rms_row_bf16(XR + (size_t)mrow * D, p.mlp_g + (size_t)layer * D, U + (size_t)mrow * D, lane);
        grid.sync();
        {
            pg8::Gemm g{U, W1T + (size_t)layer * D * FF, M, FF, D, D, D, 0}; pg8::StaticOrder S; S.init(M, FF, G, (int)blockIdx.x);
            pg8::EpiBf16<2> E{H1, FF, 0, 1.f};
            pg8::gemm_phase(lds, g, S, E);
        }
        grid.sync();
        {
            pg8::Gemm g{H1, W2T + (size_t)layer * D * FF, M, D, FF, FF, FF, 0}; pg8::StaticOrder S; S.init(M, D, G, (int)blockIdx.x);
            pg8::EpiResF32 E{XR, XR, D, nullptr};
            pg8::gemm_phase(lds, g, S, E);
        }
        grid.sync();
    }
    for (int mrow = gw; mrow < M; mrow += NGW) rms_row_f32(XR + (size_t)mrow * D, p.fin_g, p.out + (size_t)mrow * D, lane);
}

extern "C" void kernel_launch(void* const* d_in, const int* in_sizes, int n_in, void* d_out, int out_size, void* d_ws, size_t ws_size, hipStream_t stream) {
    static int grid_blocks = 0;
    if (grid_blocks == 0) {
        int dev = 0, cus = 0, per_cu = 0;
        hipGetDevice(&dev);
        hipDeviceGetAttribute(&cus, hipDeviceAttributeMultiprocessorCount, dev);
        hipFuncSetAttribute((const void*)fwd_kernel, hipFuncAttributeMaxDynamicSharedMemorySize, LDS_BYTES);
        hipOccupancyMaxActiveBlocksPerMultiprocessor(&per_cu, (const void*)fwd_kernel, 512, LDS_BYTES);
        if (per_cu < 1) per_cu = 1;
        if (per_cu > 1) per_cu = 1;
        grid_blocks = cus * per_cu;
        if (ws_size < WS_END) { fprintf(stderr, "kernel_launch: workspace too small (%zu < %zu)\n", ws_size, (size_t)WS_END); grid_blocks = -1; }
    }
    if (grid_blocks < 0) return;
    Params p{};
    p.x = (const float*)d_in[0]; p.mix_g = (const float*)d_in[1]; p.mlp_g = (const float*)d_in[2]; p.w_in = (const float*)d_in[3]; p.gate_b = (const float*)d_in[4];
    p.head_g = (const float*)d_in[5]; p.w_out = (const float*)d_in[6]; p.pw_in = (const float*)d_in[7]; p.pw_group = (const float*)d_in[8]; p.pw_out = (const float*)d_in[9];
    p.p_scale = (const float*)d_in[10]; p.w1 = (const float*)d_in[11]; p.w2 = (const float*)d_in[12]; p.fin_g = (const float*)d_in[13];
    p.out = (float*)d_out; p.ws = (unsigned char*)d_ws;
    void* args[] = {&p};
    hipError_t e = hipLaunchCooperativeKernel((const void*)fwd_kernel, dim3(grid_blocks), dim3(512), args, LDS_BYTES, stream);
    if (e != hipSuccess) fprintf(stderr, "cooperative launch failed: %s (grid %d)\n", hipGetErrorString(e), grid_blocks);
}
```

```cpp
#include <hip/hip_runtime.h>
#include <hip/hip_cooperative_groups.h>
#include <cstdio>
#include <cstdint>
namespace cg = cooperative_groups;
#ifndef EXP
#define EXP 0
#endif

#define LAS __attribute__((address_space(3)))
typedef unsigned short bf16_t;
typedef short bf16x8 __attribute__((ext_vector_type(8)));
typedef float f32x4 __attribute__((ext_vector_type(4)));
typedef unsigned u32x4 __attribute__((ext_vector_type(4)));
typedef unsigned u32x2 __attribute__((ext_vector_type(2)));

constexpr int D = 1024, BATCH = 8, SEQ = 2048, M = BATCH * SEQ, NH = 8, DK = 64, DV = 128, FF = 4096;
constexpr int NIN = 3104, NQKVO = 3072;
constexpr float EPS = 1e-6f, SOFTCAP = 15.0f;

constexpr size_t MiB = 1u << 20;
constexpr size_t WS_WIN = 2 * MiB, WS_WO = 9 * MiB, WS_PIN = 11 * MiB, WS_WG = 13 * MiB, WS_PO = 14 * MiB;
constexpr size_t WS_W1 = 16 * MiB  , WS_W2 = 32 * MiB  ;
constexpr size_t WS_U = 48 * MiB;
constexpr size_t WS_BIG = 80 * MiB;
constexpr size_t WS_QKVO = WS_BIG;
constexpr size_t WS_G = WS_BIG + 96 * MiB;
constexpr size_t WS_HB = WS_BIG + 98 * MiB;
constexpr size_t WS_H1 = WS_BIG;
constexpr size_t WS_PA = WS_BIG, WS_PL = WS_BIG + 32 * MiB, WS_MX = WS_BIG + 64 * MiB;
constexpr size_t WS_END = WS_BIG + 162 * MiB;

__device__ __forceinline__ unsigned cvt_pk_bf16(float lo, float hi) { unsigned r; asm("v_cvt_pk_bf16_f32 %0, %1, %2" : "=v"(r) : "v"(lo), "v"(hi)); return r; }
__device__ __forceinline__ float bf_lo(unsigned u) { return __uint_as_float(u << 16); }
__device__ __forceinline__ float bf_hi(unsigned u) { return __uint_as_float(u & 0xffff0000u); }

namespace pg8 {
constexpr int BM = 256, BK = 64, HALF = 128, HTB = HALF * BK * 2, STAGE_BYTES = 8 * HTB, NXCD = 8, WGM = 8;
__host__ __device__ __forceinline__ int lds_byte(int r, int c) { const int st = (r >> 4) * 2 + (c >> 5), rr = r & 15, cc = c & 31, ob = rr * 64 + cc * 2; return st * 1024 + (ob ^ (((ob >> 9) & 1) << 5)); }
__host__ __device__ __forceinline__ void stage_rc(int b, int& R, int& C) { const int st = b / 1024, sb = b % 1024, swz = sb ^ (((sb >> 9) & 1) << 5); R = (st >> 1) * 16 + swz / 64; C = (st & 1) * 32 + (swz % 64) / 2; }
__host__ __device__ __forceinline__ int perm32(int rho) { const int n = rho >> 4, i = rho & 15; return 8 * (i >> 2) + 4 * n + (i & 3); }

struct Unit { int pm, pn; };
struct Gemm { const bf16_t* A; const bf16_t* Bt; int M, N, K, lda, ldb, acol; };

struct StaticOrder {
    int nM, nN, nwg, G, c;
    __host__ __device__ void init(int M_, int N_, int G_, int c_) { nM = M_ / BM; nN = N_ / BM; nwg = nM * nN; G = G_; c = c_; }
    __host__ __device__ bool next(int i, Unit& u) const {
        const long L = (long)i * G + c; if (L >= nwg) return false;
        int wgid = (int)L; { const int q = nwg / NXCD, r = nwg % NXCD, xcd = wgid % NXCD, off = wgid / NXCD; wgid = (xcd < r ? xcd * (q + 1) : r * (q + 1) + (xcd - r) * q) + off; }
        const int nig = WGM * nN, gid = wgid / nig, fm = gid * WGM, gsz = (nM - fm) < WGM ? (nM - fm) : WGM;
        u.pm = fm + ((wgid % nig) % gsz); u.pn = (wgid % nig) / gsz; return true;
    }
};

template <int ACT  > struct EpiBf16 {
    static constexpr bool PERM = true;
    bf16_t* O; int ldc; int qtiles; float qscale;
    __device__ __forceinline__ void operator()(const f32x4 (&acc)[2][2][4][2], const Unit& u, int wr, int wc, int fr, int fq) const {
        const int row0 = u.pm * BM + wr * 64 + fr; const int col0 = u.pn * BM + wc * 32 + 8 * fq;
        const float sc = (u.pn < qtiles) ? qscale : 1.f;
#pragma unroll
        for (int ai = 0; ai < 2; ++ai)
#pragma unroll
            for (int m = 0; m < 4; ++m) { bf16_t* rowp = O + (size_t)(row0 + ai * HALF + m * 16) * ldc + col0;
#pragma unroll
                for (int bj = 0; bj < 2; ++bj) { f32x4 v0 = acc[ai][bj][m][0], v1 = acc[ai][bj][m][1];
                    if (ACT == 2) {
#pragma unroll
                        for (int e = 0; e < 4; ++e) { float a = fmaxf(v0[e], 0.f); v0[e] = a * a; float b = fmaxf(v1[e], 0.f); v1[e] = b * b; } }
                    v0 = v0 * sc; v1 = v1 * sc; u32x4 w; w.x = cvt_pk_bf16(v0[0], v0[1]); w.y = cvt_pk_bf16(v0[2], v0[3]); w.z = cvt_pk_bf16(v1[0], v1[1]); w.w = cvt_pk_bf16(v1[2], v1[3]);
                    *(u32x4*)(rowp + bj * HALF) = w; } }
    }
};
struct EpiResF32 {
    static constexpr bool PERM = false;
    const float* base; float* out; int ldc; const float* cscale;
    __device__ __forceinline__ void operator()(const f32x4 (&acc)[2][2][4][2], const Unit& u, int wr, int wc, int fr, int fq) const {
        const int col0 = u.pn * BM + wc * 32 + 4 * fq;
        f32x4 cs[2][2];
#pragma unroll
        for (int bj = 0; bj < 2; ++bj)
#pragma unroll
            for (int n = 0; n < 2; ++n) cs[bj][n] = cscale ? *(const f32x4*)(cscale + col0 + bj * HALF + n * 16) : (f32x4){1.f, 1.f, 1.f, 1.f};
#pragma unroll
        for (int ai = 0; ai < 2; ++ai)
#pragma unroll
            for (int m = 0; m < 4; ++m) { const size_t off = (size_t)(u.pm * BM + ai * HALF + wr * 64 + m * 16 + fr) * ldc + col0;
#pragma unroll
                for (int bj = 0; bj < 2; ++bj)
#pragma unroll
                    for (int n = 0; n < 2; ++n) { const f32x4 bs = *(const f32x4*)(base + off + bj * HALF + n * 16); *(f32x4*)(out + off + bj * HALF + n * 16) = bs + acc[ai][bj][m][n] * cs[bj][n]; } }
    }
};

template <class Epi>
__device__ __forceinline__ void gemm_phase(LAS unsigned char* lds, const Gemm g, const StaticOrder& S, const Epi& E) {
    int tid_ = threadIdx.x; asm volatile("" : "+v"(tid_));
    const int tid = tid_, wid = __builtin_amdgcn_readfirstlane(tid >> 6), lane = tid & 63, wr = wid >> 2, wc = wid & 3, fr = lane & 15, fq = lane >> 4;
    const int nt = g.K / BK;
    unsigned voffA[2], voffB[2];
#pragma unroll
    for (int i = 0; i < 2; ++i) { int R, C; stage_rc(tid * 16 + i * 8192, R, C); const int Rb = Epi::PERM ? ((R & ~31) + perm32(R & 31)) : R;
        voffA[i] = (unsigned)(R * g.lda + C) * 2u; voffB[i] = (unsigned)(Rb * g.ldb + C) * 2u; }
    const size_t kstep = (size_t)(BK * 2);
    const size_t hstepA = (size_t)HALF * g.lda * 2, hstepB = (size_t)HALF * g.ldb * 2;
    const size_t tstepA = 2 * hstepA, tstepB = 2 * hstepB;
    const unsigned ldsw = (unsigned)wid * 1024u;
    const int aoff = lds_byte(wr * 64 + fr, fq * 8), boff = lds_byte(wc * 32 + fr, fq * 8);
#define PG8_SA(b, h) (((b) * 2 + (h)) * HTB)
#define PG8_SB(b, h) ((4 + (b) * 2 + (h)) * HTB)
#define PG8_STAGE(bufoff, gbase, voff) do { _Pragma("unroll") for (int _i = 0; _i < 2; ++_i) \
        __builtin_amdgcn_global_load_lds((const unsigned*)((const char*)(gbase) + (voff)[_i]), (LAS unsigned*)(lds + (bufoff) + ldsw + _i * 8192), 16, 0, 0); } while (0)
#define PG8_LDA(dst, b, h) do { _Pragma("unroll") for (int m = 0; m < 4; ++m) _Pragma("unroll") for (int k = 0; k < 2; ++k) dst[m][k] = *(const LAS bf16x8*)(lds + PG8_SA(b, h) + aoff + m * 2048 + k * 1024); } while (0)
#define PG8_LDB(dst, b, h) do { _Pragma("unroll") for (int n = 0; n < 2; ++n) _Pragma("unroll") for (int k = 0; k < 2; ++k) dst[n][k] = *(const LAS bf16x8*)(lds + PG8_SB(b, h) + boff + n * 2048 + k * 1024); } while (0)
#define PG8_MMA(ai, bj, At, Bt) do { __builtin_amdgcn_s_setprio(1); _Pragma("unroll") for (int m = 0; m < 4; ++m) _Pragma("unroll") for (int n = 0; n < 2; ++n) _Pragma("unroll") for (int k = 0; k < 2; ++k) \
        acc[ai][bj][m][n] = __builtin_amdgcn_mfma_f32_16x16x32_bf16(Bt[n][k], At[m][k], acc[ai][bj][m][n], 0, 0, 0); __builtin_amdgcn_s_setprio(0); } while (0)
#define PG8_WAIT_V(n) asm volatile("s_waitcnt vmcnt(" #n ")" ::: "memory")
#define PG8_WAIT_L(n) asm volatile("s_waitcnt lgkmcnt(" #n ")" ::: "memory")
#define PG8_BAR __builtin_amdgcn_s_barrier()
#define PG8_SCHED __builtin_amdgcn_sched_barrier(0)
    Unit cur, nxt; int ui = 0;
    if (!S.next(0, cur)) return;
    f32x4 acc[2][2][4][2];
#pragma unroll
    for (int a = 0; a < 2; ++a)
#pragma unroll
        for (int b = 0; b < 2; ++b)
#pragma unroll
            for (int m = 0; m < 4; ++m)
#pragma unroll
                for (int n = 0; n < 2; ++n) acc[a][b][m][n] = (f32x4){0.f, 0.f, 0.f, 0.f};
    bf16x8 At[4][2], B0[2][2], B1[2][2];
    const char* cA = (const char*)g.A + (size_t)cur.pm * tstepA + (size_t)cur.pn * g.acol * 2; const char* cB = (const char*)g.Bt + (size_t)cur.pn * tstepB;
    PG8_STAGE(PG8_SB(0, 0), cB, voffB); PG8_STAGE(PG8_SB(0, 1), cB + hstepB, voffB); PG8_STAGE(PG8_SA(0, 0), cA, voffA); PG8_STAGE(PG8_SA(0, 1), cA + hstepA, voffA);
    if (wr == 1) PG8_BAR;
    PG8_WAIT_V(2); PG8_BAR;
    PG8_STAGE(PG8_SB(1, 0), cB + kstep, voffB); PG8_STAGE(PG8_SA(1, 0), cA + kstep, voffA); PG8_STAGE(PG8_SB(1, 1), cB + hstepB + kstep, voffB);
    PG8_WAIT_V(6); PG8_BAR;
    for (;;) {
        const bool has_next = S.next(ui + 1, nxt);
        const char* nA = has_next ? (const char*)g.A + (size_t)nxt.pm * tstepA + (size_t)nxt.pn * g.acol * 2 : cA; const char* nB = has_next ? (const char*)g.Bt + (size_t)nxt.pn * tstepB : cB;
        for (int t = 0; t < nt; t += 2) {
            const bool last = (t == nt - 2);
            const char* a1 = cA + (size_t)(t + 1) * kstep;
            const char* a2 = last ? nA : cA + (size_t)(t + 2) * kstep; const char* b2 = last ? nB : cB + (size_t)(t + 2) * kstep;
            const char* a3 = a2 + kstep; const char* b3 = b2 + kstep;
            PG8_LDB(B0, 0, 0); PG8_LDB(B1, 0, 1); PG8_SCHED; PG8_LDA(At, 0, 0); PG8_STAGE(PG8_SA(1, 1), a1 + hstepA, voffA);
            PG8_WAIT_V(8); PG8_WAIT_L(0); PG8_BAR; PG8_MMA(0, 0, At, B0); PG8_MMA(0, 1, At, B1); PG8_BAR; PG8_SCHED;
            PG8_LDA(At, 0, 1); PG8_STAGE(PG8_SB(0, 0), b2, voffB); PG8_STAGE(PG8_SB(0, 1), b2 + hstepB, voffB); PG8_STAGE(PG8_SA(0, 0), a2, voffA);
            PG8_WAIT_V(8); PG8_WAIT_L(0); PG8_BAR; PG8_MMA(1, 0, At, B0); PG8_MMA(1, 1, At, B1); PG8_BAR; PG8_SCHED;
            PG8_LDB(B0, 1, 0); PG8_LDB(B1, 1, 1); PG8_SCHED; PG8_LDA(At, 1, 0); PG8_STAGE(PG8_SA(0, 1), a2 + hstepA, voffA);
            PG8_WAIT_V(8); PG8_WAIT_L(0); PG8_BAR; PG8_MMA(0, 0, At, B0); PG8_MMA(0, 1, At, B1); PG8_BAR; PG8_SCHED;
            PG8_LDA(At, 1, 1); PG8_STAGE(PG8_SB(1, 0), b3, voffB); PG8_STAGE(PG8_SB(1, 1), b3 + hstepB, voffB); PG8_STAGE(PG8_SA(1, 0), a3, voffA);
            PG8_WAIT_V(8); PG8_WAIT_L(0); PG8_BAR; PG8_MMA(1, 0, At, B0); PG8_MMA(1, 1, At, B1); PG8_BAR; PG8_SCHED;
        }
        if (wr == 0) PG8_BAR;
        E(acc, cur, wr, wc, fr, fq);
        if (!has_next) break;
#pragma unroll
        for (int a = 0; a < 2; ++a)
#pragma unroll
            for (int b = 0; b < 2; ++b)
#pragma unroll
                for (int m = 0; m < 4; ++m)
#pragma unroll
                    for (int n = 0; n < 2; ++n) acc[a][b][m][n] = (f32x4){0.f, 0.f, 0.f, 0.f};
        cur = nxt; cA = nA; cB = nB; ++ui;
        if (wr == 1) PG8_BAR;
    }
    PG8_WAIT_V(0);
    PG8_BAR;
#undef PG8_SA
#undef PG8_SB
#undef PG8_STAGE
#undef PG8_LDA
#undef PG8_LDB
#undef PG8_MMA
#undef PG8_WAIT_V
#undef PG8_WAIT_L
#undef PG8_BAR
#undef PG8_SCHED
}
}


#define XB_TMO      128
#define XB_XCNT(j)  (256  + 64 * (j))
#define XB_XSUB(j)  (1280 + 64 * (j))
#define XB_XGEN(j)  (2304 + 64 * (j))
#define XB_TOP      3328
#define XB_TOPGEN   3392
#define XCD_BAR_WORDS 3456
#define XB_SPIN_CAP (1u << 18)
__device__ __forceinline__ unsigned xb_ld(unsigned* p)              { return __hip_atomic_load(p, __ATOMIC_RELAXED, __HIP_MEMORY_SCOPE_AGENT); }
__device__ __forceinline__ unsigned xb_add(unsigned* p, unsigned v) { return __hip_atomic_fetch_add(p, v, __ATOMIC_RELAXED, __HIP_MEMORY_SCOPE_AGENT); }
__device__ __forceinline__ unsigned xb_xcc_id() { return (unsigned)__builtin_amdgcn_s_getreg((3 << 11) | 20) & 0xFu; }
#define XB_SPIN(cond, bar) do { unsigned _sp = 0; while (cond) { __builtin_amdgcn_s_sleep(1); \
    if ((++_sp & 255u) == 0u) { if (xb_ld(&(bar)[XB_TMO])) break; if (_sp > XB_SPIN_CAP) { atomicAdd(&(bar)[XB_TMO], 1u); break; } } } } while (0)
struct XcdBarrier { unsigned* bar; unsigned x; volatile LAS unsigned* st; };
__device__ __forceinline__ XcdBarrier xcd_barrier_post(unsigned* bar, volatile LAS unsigned* st) {
    XcdBarrier b; b.bar = bar; b.x = xb_xcc_id(); b.st = st;
    if (threadIdx.x == 0) (void)xb_add(&bar[XB_XCNT(b.x)], 1u);
    return b;
}
__device__ __forceinline__ void xcd_barrier_complete(unsigned* bar, unsigned x, unsigned& nloc, unsigned& nx) {
    const unsigned G = gridDim.x * gridDim.y * gridDim.z;
    unsigned sum, cnt, mine, sp = 0u;
    for (;;) {
        sum = 0u; cnt = 0u; mine = 0u;
#pragma unroll
        for (unsigned j = 0; j < 16; ++j) { const unsigned c = xb_ld(&bar[XB_XCNT(j)]); sum += c; cnt += (c > 0u) ? 1u : 0u; mine = (j == x) ? c : mine; }
        if (sum == G) break;
        __builtin_amdgcn_s_sleep(1);
        if ((++sp & 255u) == 0u) { if (xb_ld(&bar[XB_TMO])) break; if (sp > XB_SPIN_CAP) { atomicAdd(&bar[XB_TMO], 1u); break; } }
    }
    nloc = mine > 0u ? mine : 1u; nx = cnt > 0u ? cnt : 1u;
}
__device__ __forceinline__ void xcd_barrier(unsigned* const bbar, const unsigned bx, volatile LAS unsigned* const bst) {
    asm volatile("s_waitcnt vmcnt(0)" ::: "memory");
    __syncthreads();
    if (threadIdx.x == 0) {
        unsigned* bar = bbar;
        __builtin_amdgcn_s_waitcnt(0);
        unsigned nloc = bst[0], nx = bst[1];
        if (nloc == 0u) { xcd_barrier_complete(bar, bx, nloc, nx); bst[0] = nloc; bst[1] = nx; }
        const unsigned old = xb_add(&bar[XB_XSUB(bx)], 1u);
        const unsigned gen = old / nloc;
        if (old + 1u == (gen + 1u) * nloc) {
            __builtin_amdgcn_fence(__ATOMIC_RELEASE, "agent");
            asm volatile("s_waitcnt vmcnt(0)" ::: "memory");
            const unsigned og = xb_add(&bar[XB_TOP], 1u);
            const unsigned tg = og / nx;
            if (og + 1u == (tg + 1u) * nx) xb_add(&bar[XB_TOPGEN], 1u);
            else XB_SPIN(xb_ld(&bar[XB_TOPGEN]) == tg, bar);
            __builtin_amdgcn_fence(__ATOMIC_ACQUIRE, "agent");
            xb_add(&bar[XB_XGEN(bx)], 1u);
            asm volatile("s_waitcnt vmcnt(0)" ::: "memory");
        } else {
            XB_SPIN(xb_ld(&bar[XB_XGEN(bx)]) == gen, bar);
            __builtin_amdgcn_fence(__ATOMIC_ACQUIRE, "agent");
            asm volatile("s_waitcnt vmcnt(0)" ::: "memory");
        }
    }
    __syncthreads();
}

__device__ __forceinline__ float wave_sum(float v) {
#pragma unroll
    for (int o = 1; o < 64; o <<= 1) v += __shfl_xor(v, o);
    return v;
}
__device__ __forceinline__ float wave_incl_sum(float v, int lane) {
#pragma unroll
    for (int o = 1; o < 64; o <<= 1) { const float t = __shfl_up(v, o); if (lane >= o) v += t; }
    return v;
}
__device__ __forceinline__ float wave_incl_max(float v, int lane) {
#pragma unroll
    for (int o = 1; o < 64; o <<= 1) { const float t = __shfl_up(v, o); if (lane >= o) v = fmaxf(v, t); }
    return v;
}

__device__ __forceinline__ void transpose_item(const float* W, int K, int N, bf16_t* WT, LAS float* scr, int item, int lane) {
    const int nblk = N / 32, kb = item / nblk, nb = item % nblk, k0 = 64 * kb, n0 = 32 * nb;
#pragma unroll 8
    for (int i = 0; i < 32; ++i) { const int kk = 2 * i + (lane >> 5); scr[kk * 33 + (lane & 31)] = W[(size_t)(k0 + kk) * N + n0 + (lane & 31)]; }
    asm volatile("s_waitcnt lgkmcnt(0)" ::: "memory");
    const int c = lane & 7;
#pragma unroll
    for (int j = 0; j < 4; ++j) { const int n = (lane >> 3) + 8 * j; const LAS float* s = scr + (8 * c) * 33 + n;
        u32x4 o; o.x = cvt_pk_bf16(s[0 * 33], s[1 * 33]); o.y = cvt_pk_bf16(s[2 * 33], s[3 * 33]); o.z = cvt_pk_bf16(s[4 * 33], s[5 * 33]); o.w = cvt_pk_bf16(s[6 * 33], s[7 * 33]);
        *(u32x4*)(WT + (size_t)(n0 + n) * K + k0 + 8 * c) = o; }
    asm volatile("s_waitcnt lgkmcnt(0)" ::: "memory");
}

__device__ __forceinline__ void rms_row_bf16(const float* xrow, const float* g, bf16_t* orow, int lane) {
    const f32x4* xr = (const f32x4*)xrow + lane; const f32x4* gr = (const f32x4*)g + lane;
    f32x4 v[4]; float s = 0.f;
#pragma unroll
    for (int j = 0; j < 4; ++j) { v[j] = xr[64 * j]; s += (v[j].x * v[j].x + v[j].y * v[j].y) + (v[j].z * v[j].z + v[j].w * v[j].w); }
    const float r = 1.0f / sqrtf(wave_sum(s) * (1.f / D) + EPS);
    u32x2* o8 = (u32x2*)orow + lane;
#pragma unroll
    for (int j = 0; j < 4; ++j) { const f32x4 gg = gr[64 * j]; u32x2 w; w.x = cvt_pk_bf16(v[j].x * r * gg.x, v[j].y * r * gg.y); w.y = cvt_pk_bf16(v[j].z * r * gg.z, v[j].w * r * gg.w); o8[64 * j] = w; }
}
__device__ __forceinline__ void rms_row_f32(const float* xrow, const float* g, float* orow, int lane) {
    const f32x4* xr = (const f32x4*)xrow + lane; const f32x4* gr = (const f32x4*)g + lane;
    f32x4 v[4]; float s = 0.f;
#pragma unroll
    for (int j = 0; j < 4; ++j) { v[j] = xr[64 * j]; s += (v[j].x * v[j].x + v[j].y * v[j].y) + (v[j].z * v[j].z + v[j].w * v[j].w); }
    const float r = 1.0f / sqrtf(wave_sum(s) * (1.f / D) + EPS);
    f32x4* o = (f32x4*)orow + lane;
#pragma unroll
    for (int j = 0; j < 4; ++j) { const f32x4 gg = gr[64 * j]; o[64 * j] = v[j] * r * gg; }
}

constexpr int LS = 72;
constexpr int ML_Q = 0, ML_K = 9216, ML_KWT = 18432, ML_VT = 27648, ML_CT = 39168, ML_END = 50688;

__device__ __forceinline__ void mlstm_phase(LAS unsigned char* lds, const bf16_t* QKVO, const float* Gt, float* HF, float* HB, int tid, int lane, int wave) {
    const int fr = lane & 15, fq = lane >> 4, tt = wave & 3, vs = wave >> 2;
    LAS bf16_t* Qs = (LAS bf16_t*)(lds + ML_Q); LAS bf16_t* Ks = (LAS bf16_t*)(lds + ML_K); LAS bf16_t* KwT = (LAS bf16_t*)(lds + ML_KWT);
    LAS bf16_t* VT = (LAS bf16_t*)(lds + ML_VT); LAS bf16_t* CT = (LAS bf16_t*)(lds + ML_CT);
    for (int item = blockIdx.x; item < 256; item += gridDim.x) {
        const int vh = item & 1, dir = (item >> 1) & 1, h = (item >> 2) & 7, b = item >> 5;
        const bf16_t* qb = QKVO + (size_t)b * SEQ * NQKVO + h * DK + 8 * wave;
        const bf16_t* kb = qb + 512;
        const bf16_t* vb = QKVO + (size_t)b * SEQ * NQKVO + 1024 + h * DV + vh * 64 + 8 * wave;
        const float* gi = Gt + (size_t)b * SEQ * 32 + (2 * dir) * 8 + h; const float* gf = gi + 8;
        float* Hout = (dir ? HB : HF) + (size_t)b * SEQ * D + h * DV + vh * 64;
        __syncthreads();
        for (int idx = tid; idx < 16 * 64; idx += 512) { const int r = 64 + (idx >> 6), c = idx & 63; VT[r * LS + c] = (r == 64) ? (bf16_t)0x3F80 : (bf16_t)0; }
        f32x4 accC[3];
#pragma unroll
        for (int i = 0; i < 3; ++i) accC[i] = (f32x4){0.f, 0.f, 0.f, 0.f};
        float m = 0.f;
        int pos = dir ? (SEQ - 1 - lane) : lane;
        u32x4 q16 = *(const u32x4*)(qb + (size_t)pos * NQKVO), k16 = *(const u32x4*)(kb + (size_t)pos * NQKVO), v16 = *(const u32x4*)(vb + (size_t)pos * NQKVO);
        float li = gi[(size_t)pos * 32], lf = gf[(size_t)pos * 32];
        for (int j = 0; j < SEQ / 64; ++j) {
            const float bcs = wave_incl_sum(lf, lane);
            const float a = li - bcs;
            const float cm = wave_incl_max(a, lane);
            const float Mv = fmaxf(m, cm);
            const float b_last = __shfl(bcs, 63), M63 = __shfl(Mv, 63);
            const float decay = __expf(m - M63);
            const float wk = __expf(a - M63);
            *(LAS u32x4*)(Qs + lane * LS + 8 * wave) = q16;
            *(LAS u32x4*)(Ks + lane * LS + 8 * wave) = k16;
            {
                const unsigned kk[4] = {k16.x, k16.y, k16.z, k16.w}, vv[4] = {v16.x, v16.y, v16.z, v16.w};
#pragma unroll
                for (int e = 0; e < 4; ++e) {
                    const unsigned kw = cvt_pk_bf16(bf_lo(kk[e]) * wk, bf_hi(kk[e]) * wk);
                    KwT[(8 * wave + 2 * e) * LS + lane] = (bf16_t)(kw & 0xffffu); KwT[(8 * wave + 2 * e + 1) * LS + lane] = (bf16_t)(kw >> 16);
                    VT[(8 * wave + 2 * e) * LS + lane] = (bf16_t)(vv[e] & 0xffffu); VT[(8 * wave + 2 * e + 1) * LS + lane] = (bf16_t)(vv[e] >> 16);
                }
            }
            {
                const int nvt = vs ? 2 : 3, vt0 = vs ? 3 : 0;
#pragma unroll
                for (int vi = 0; vi < 3; ++vi) if (vi < nvt) {
                    u32x2 w; w.x = cvt_pk_bf16(accC[vi][0], accC[vi][1]); w.y = cvt_pk_bf16(accC[vi][2], accC[vi][3]);
                    *(LAS u32x2*)(CT + (16 * (vt0 + vi) + fr) * LS + 16 * tt + 4 * fq) = w; }
            }
            __syncthreads();
            u32x4 q16n = q16, k16n = k16, v16n = v16; float lin = li, lfn = lf;
            if (j + 1 < SEQ / 64) {
                const int pn = dir ? (SEQ - 1 - (64 * (j + 1) + lane)) : (64 * (j + 1) + lane);
                q16n = *(const u32x4*)(qb + (size_t)pn * NQKVO); k16n = *(const u32x4*)(kb + (size_t)pn * NQKVO); v16n = *(const u32x4*)(vb + (size_t)pn * NQKVO);
                lin = gi[(size_t)pn * 32]; lfn = gf[(size_t)pn * 32];
            }
            bf16x8 qf[2];
            qf[0] = *(const LAS bf16x8*)(Qs + (16 * tt + fr) * LS + 8 * fq); qf[1] = *(const LAS bf16x8*)(Qs + (16 * tt + fr) * LS + 32 + 8 * fq);
            const float Mt = __shfl(Mv, 16 * tt + fr), bt = __shfl(bcs, 16 * tt + fr);
            float p[4][4];
#pragma unroll
            for (int st = 0; st < 4; ++st) {
                f32x4 s4 = (f32x4){0.f, 0.f, 0.f, 0.f};
                if (st <= tt) {
                    const bf16x8 kf0 = *(const LAS bf16x8*)(Ks + (16 * st + fr) * LS + 8 * fq), kf1 = *(const LAS bf16x8*)(Ks + (16 * st + fr) * LS + 32 + 8 * fq);
                    s4 = __builtin_amdgcn_mfma_f32_16x16x32_bf16(kf0, qf[0], s4, 0, 0, 0);
                    s4 = __builtin_amdgcn_mfma_f32_16x16x32_bf16(kf1, qf[1], s4, 0, 0, 0);
                }
#pragma unroll
                for (int i = 0; i < 4; ++i) {
                    const int sidx = 16 * st + 4 * fq + i;
                    const float as = __shfl(a, sidx);
                    const float w = (sidx <= 16 * tt + fr) ? __expf(as - Mt) : 0.f;
                    p[st][i] = s4[i] * w;
                }
            }
            bf16x8 pb[2];
#pragma unroll
            for (int kk2 = 0; kk2 < 2; ++kk2) {
                u32x4 w; w.x = cvt_pk_bf16(p[2 * kk2][0], p[2 * kk2][1]); w.y = cvt_pk_bf16(p[2 * kk2][2], p[2 * kk2][3]);
                w.z = cvt_pk_bf16(p[2 * kk2 + 1][0], p[2 * kk2 + 1][1]); w.w = cvt_pk_bf16(p[2 * kk2 + 1][2], p[2 * kk2 + 1][3]);
                pb[kk2] = __builtin_bit_cast(bf16x8, w);
            }
            const float sc = __expf(m - Mt);
            f32x4 num[3];
#pragma unroll
            for (int vi = 0; vi < 3; ++vi) {
                const int vt = (vi < 2) ? (2 * vs + vi) : 4;
                f32x4 a1 = (f32x4){0.f, 0.f, 0.f, 0.f}, a2 = (f32x4){0.f, 0.f, 0.f, 0.f};
#pragma unroll
                for (int kk2 = 0; kk2 < 2; ++kk2) {
                    const u32x2 lo = *(const LAS u32x2*)(VT + (16 * vt + fr) * LS + 32 * kk2 + 4 * fq), hi = *(const LAS u32x2*)(VT + (16 * vt + fr) * LS + 32 * kk2 + 16 + 4 * fq);
                    const u32x4 vv = (u32x4){lo.x, lo.y, hi.x, hi.y};
                    a1 = __builtin_amdgcn_mfma_f32_16x16x32_bf16(__builtin_bit_cast(bf16x8, vv), pb[kk2], a1, 0, 0, 0);
                    const bf16x8 cf = *(const LAS bf16x8*)(CT + (16 * vt + fr) * LS + 32 * kk2 + 8 * fq);
                    a2 = __builtin_amdgcn_mfma_f32_16x16x32_bf16(cf, qf[kk2], a2, 0, 0, 0);
                }
                num[vi] = a1 + a2 * sc;
            }
            const float den = __shfl(num[2][0], fr);
            const float inv = 1.0f / fmaxf(fabsf(den), __expf(-(bt + Mt)));
            {
                const int tl = 64 * j + 16 * tt + fr; const int post = dir ? (SEQ - 1 - tl) : tl;
#pragma unroll
                for (int vi = 0; vi < 2; ++vi) *(f32x4*)(Hout + (size_t)post * D + 16 * (2 * vs + vi) + 4 * fq) = num[vi] * inv;
            }
            {
                const int nvt = vs ? 2 : 3, vt0 = vs ? 3 : 0;
                const bf16x8 kf0 = *(const LAS bf16x8*)(KwT + (16 * tt + fr) * LS + 8 * fq), kf1 = *(const LAS bf16x8*)(KwT + (16 * tt + fr) * LS + 32 + 8 * fq);
#pragma unroll
                for (int vi = 0; vi < 3; ++vi) if (vi < nvt) {
                    const bf16x8 vf0 = *(const LAS bf16x8*)(VT + (16 * (vt0 + vi) + fr) * LS + 8 * fq), vf1 = *(const LAS bf16x8*)(VT + (16 * (vt0 + vi) + fr) * LS + 32 + 8 * fq);
                    f32x4 c = accC[vi] * decay;
                    c = __builtin_amdgcn_mfma_f32_16x16x32_bf16(kf0, vf0, c, 0, 0, 0);
                    c = __builtin_amdgcn_mfma_f32_16x16x32_bf16(kf1, vf1, c, 0, 0, 0);
                    accC[vi] = c; }
            }
            m = b_last + M63;
            __syncthreads();
            q16 = q16n; k16 = k16n; v16 = v16n; li = lin; lf = lfn;
        }
    }
}

struct Params {
    const float* x; const float* mix_g; const float* mlp_g; const float* w_in; const float* gate_b; const float* head_g; const float* w_out;
    const float* pw_in; const float* pw_group; const float* pw_out; const float* p_scale; const float* w1; const float* w2; const float* fin_g;
    float* out; unsigned char* ws;
};
constexpr int LDS_BYTES = 147456;

__global__ void __launch_bounds__(512, 2) fwd_kernel(Params p) {
    extern __shared__ __attribute__((aligned(16))) unsigned char lds_raw[];
    LAS unsigned char* lds = (LAS unsigned char*)lds_raw;
    cg::grid_group grid = cg::this_grid();
    if (p.ws == nullptr) grid.sync();
    volatile LAS unsigned* MISC = (volatile LAS unsigned*)(lds + 131072 + 320);
    if (threadIdx.x < 32) MISC[threadIdx.x] = 0u;
    __syncthreads();
    unsigned* const xb_bar = (unsigned*)p.ws + 4096; const unsigned xb_x = xb_xcc_id();
    if (threadIdx.x == 0) (void)xb_add(&xb_bar[XB_XCNT(xb_x)], 1u);
#if EXP == 2
#define GSYNC() do { xcd_barrier(xb_bar, xb_x, MISC + 8); xcd_barrier(xb_bar, xb_x, MISC + 8); } while (0)
#else
#define GSYNC() xcd_barrier(xb_bar, xb_x, MISC + 8)
#endif
    const int G = gridDim.x, NGW = G * 8;
#define LANE_INIT int tid = threadIdx.x; asm volatile("" : "+v"(tid)); const int lane = tid & 63, wave = __builtin_amdgcn_readfirstlane(tid >> 6), gw = blockIdx.x * 8 + wave; (void)gw; (void)lane;
    unsigned char* ws = p.ws;
    bf16_t* WinT = (bf16_t*)(ws + WS_WIN); bf16_t* WoT = (bf16_t*)(ws + WS_WO); bf16_t* PinT = (bf16_t*)(ws + WS_PIN); bf16_t* WgT = (bf16_t*)(ws + WS_WG); bf16_t* PoT = (bf16_t*)(ws + WS_PO);
    bf16_t* W1T = (bf16_t*)(ws + WS_W1); bf16_t* W2T = (bf16_t*)(ws + WS_W2);
    bf16_t* U = (bf16_t*)(ws + WS_U); bf16_t* QKVO = (bf16_t*)(ws + WS_QKVO); float* Gt = (float*)(ws + WS_G); float* HB = (float*)(ws + WS_HB); float* HF = p.out;
    bf16_t* H1 = (bf16_t*)(ws + WS_H1); bf16_t* PA = (bf16_t*)(ws + WS_PA); bf16_t* PL = (bf16_t*)(ws + WS_PL); bf16_t* MX = (bf16_t*)(ws + WS_MX);
    float* XR = p.out;

    {
        LANE_INIT
        LAS float* scr = (LAS float*)(lds + wave * 16384);
        constexpr int I_IN = (D / 64) * (NIN / 32), I_SQ = (D / 64) * (D / 32), I_G = (256 / 64) * (256 / 32), I_1 = (D / 64) * (FF / 32), I_2 = (FF / 64) * (D / 32);
        constexpr int NITEMS = I_IN + 3 * I_SQ + 4 * I_G + 2 * I_1 + 2 * I_2;
        for (int it = gw; it < NITEMS; it += NGW) {
            int r = it;
            if (r < I_IN) { transpose_item(p.w_in, D, NIN, WinT, scr, r, lane); continue; } r -= I_IN;
            if (r < I_SQ) { transpose_item(p.w_out, D, D, WoT, scr, r, lane); continue; } r -= I_SQ;
            if (r < I_SQ) { transpose_item(p.pw_in, D, D, PinT, scr, r, lane); continue; } r -= I_SQ;
            if (r < I_SQ) { transpose_item(p.pw_out, D, D, PoT, scr, r, lane); continue; } r -= I_SQ;
            if (r < 4 * I_G) { const int g = r / I_G; transpose_item(p.pw_group + (size_t)g * 65536, 256, 256, WgT + (size_t)g * 65536, scr, r % I_G, lane); continue; } r -= 4 * I_G;
            if (r < 2 * I_1) { const int l = r / I_1; transpose_item(p.w1 + (size_t)l * D * FF, D, FF, W1T + (size_t)l * D * FF, scr, r % I_1, lane); continue; } r -= 2 * I_1;
            { const int l = r / I_2; transpose_item(p.w2 + (size_t)l * D * FF, FF, D, W2T + (size_t)l * D * FF, scr, r % I_2, lane); }
        }
        for (int mrow = gw; mrow < M; mrow += NGW) rms_row_bf16(p.x + (size_t)mrow * D, p.mix_g, U + (size_t)mrow * D, lane);
    }
    GSYNC();

    {
        pg8::Gemm g{U, WinT, M, NQKVO, D, D, D, 0}; pg8::StaticOrder S; S.init(M, NQKVO, G, (int)blockIdx.x);
        pg8::EpiBf16<0> E{QKVO, NQKVO, 2, 0.125f};
        pg8::gemm_phase(lds, g, S, E);
        LANE_INIT
        const int fr = lane & 15, fq = lane >> 4;
        for (int job = gw; job < M / 16; job += NGW) {
            const int tok0 = job * 16;
            const bf16_t* ap0 = WinT + (size_t)(NQKVO + fr) * D + 8 * fq; const bf16_t* ap1 = ap0 + 16 * D; const bf16_t* bp = U + (size_t)(tok0 + fr) * D + 8 * fq;
            f32x4 acc0 = (f32x4){0.f, 0.f, 0.f, 0.f}, acc1 = (f32x4){0.f, 0.f, 0.f, 0.f};
#pragma unroll 4
            for (int ks = 0; ks < D / 32; ++ks) {
                const bf16x8 a0 = *(const bf16x8*)(ap0 + 32 * ks), a1 = *(const bf16x8*)(ap1 + 32 * ks), bb = *(const bf16x8*)(bp + 32 * ks);
                acc0 = __builtin_amdgcn_mfma_f32_16x16x32_bf16(a0, bb, acc0, 0, 0, 0);
                acc1 = __builtin_amdgcn_mfma_f32_16x16x32_bf16(a1, bb, acc1, 0, 0, 0);
            }
#pragma unroll
            for (int nt = 0; nt < 2; ++nt) {
                const int n0 = 16 * nt + 4 * fq; const f32x4 bias = *(const f32x4*)(p.gate_b + n0);
                f32x4 gv = (nt ? acc1 : acc0) + bias;
                const bool isf = ((n0 >> 3) & 1) != 0;
#pragma unroll
                for (int e = 0; e < 4; ++e) { float t = SOFTCAP * tanhf(gv[e] * (1.0f / SOFTCAP)); if (isf) t = fminf(t, 0.f) - log1pf(expf(-fabsf(t))); gv[e] = t; }
                *(f32x4*)(Gt + (size_t)(tok0 + fr) * 32 + n0) = gv;
            }
        }
    }
    GSYNC();

    { LANE_INIT mlstm_phase(lds, QKVO, Gt, HF, HB, tid, lane, wave); }
#if EXP == 1
    GSYNC(); { LANE_INIT mlstm_phase(lds, QKVO, Gt, HF, HB, tid, lane, wave); }
#endif
    GSYNC();

    { LANE_INIT
    for (int row = gw; row < M; row += NGW) {
#pragma unroll
        for (int jj = 0; jj < 4; ++jj) {
            const int c = 4 * lane + 256 * jj;
            const f32x4 hf = *(const f32x4*)(HF + (size_t)row * D + c), hb = *(const f32x4*)(HB + (size_t)row * D + c);
            const f32x4 hh = hf + hb;
            float ss = (hh.x * hh.x + hh.y * hh.y) + (hh.z * hh.z + hh.w * hh.w);
#pragma unroll
            for (int o = 1; o < 32; o <<= 1) ss += __shfl_xor(ss, o);
            const float r = 1.0f / sqrtf(ss * (1.f / DV) + EPS);
            const u32x2 ov = *(const u32x2*)(QKVO + (size_t)row * NQKVO + 2048 + c);
            const f32x4 hg = *(const f32x4*)(p.head_g + c);
            const float o0 = bf_lo(ov.x), o1 = bf_hi(ov.x), o2 = bf_lo(ov.y), o3 = bf_hi(ov.y);
            const float y0 = hh.x * r * hg.x / (1.f + __expf(-o0)), y1 = hh.y * r * hg.y / (1.f + __expf(-o1));
            const float y2 = hh.z * r * hg.z / (1.f + __expf(-o2)), y3 = hh.w * r * hg.w / (1.f + __expf(-o3));
            u32x2 w; w.x = cvt_pk_bf16(y0, y1); w.y = cvt_pk_bf16(y2, y3);
            *(u32x2*)(U + (size_t)row * D + c) = w;
        }
    } }
    GSYNC();

    {
        pg8::Gemm g{U, WoT, M, D, D, D, D, 0}; pg8::StaticOrder S; S.init(M, D, G, (int)blockIdx.x);
        pg8::EpiResF32 E{p.x, XR, D, nullptr};
        pg8::gemm_phase(lds, g, S, E);
    }
    GSYNC();

    for (int layer = 0; layer < 2; ++layer) {
        if (layer == 1) {
            { LANE_INIT for (int mrow = gw; mrow < M; mrow += NGW) rms_row_bf16(XR + (size_t)mrow * D, p.mix_g + D, U + (size_t)mrow * D, lane); }
            GSYNC();
            {
                pg8::Gemm g{U, PinT, M, D, D, D, D, 0}; pg8::StaticOrder S; S.init(M, D, G, (int)blockIdx.x);
                pg8::EpiBf16<0> E{PA, D, 0, 1.f};
                pg8::gemm_phase(lds, g, S, E);
            }
            GSYNC();
            { LANE_INIT
            for (int task = blockIdx.x * 512 + tid; task < M * 128; task += G * 512) {
                const int row = task >> 7, cgp = task & 127, gidx = cgp >> 5, w = 2 << gidx, t = row & (SEQ - 1), rb = row - t;
                const int lo = max(t - (w >> 1), 0), hi = min(t + w - (w >> 1), SEQ);
                float s[8];
#pragma unroll
                for (int e = 0; e < 8; ++e) s[e] = 0.f;
                for (int r = lo; r < hi; ++r) {
                    const u32x4 v = *(const u32x4*)(PA + (size_t)(rb + r) * D + 8 * cgp);
                    s[0] += bf_lo(v.x); s[1] += bf_hi(v.x); s[2] += bf_lo(v.y); s[3] += bf_hi(v.y); s[4] += bf_lo(v.z); s[5] += bf_hi(v.z); s[6] += bf_lo(v.w); s[7] += bf_hi(v.w);
                }
                const float ic = 1.0f / (float)(hi - lo);
                const u32x4 v = *(const u32x4*)(PA + (size_t)row * D + 8 * cgp);
                u32x4 o;
                o.x = cvt_pk_bf16(s[0] * ic - bf_lo(v.x), s[1] * ic - bf_hi(v.x)); o.y = cvt_pk_bf16(s[2] * ic - bf_lo(v.y), s[3] * ic - bf_hi(v.y));
                o.z = cvt_pk_bf16(s[4] * ic - bf_lo(v.z), s[5] * ic - bf_hi(v.z)); o.w = cvt_pk_bf16(s[6] * ic - bf_lo(v.w), s[7] * ic - bf_hi(v.w));
                *(u32x4*)(PL + (size_t)row * D + 8 * cgp) = o;
            } }
            GSYNC();
            {
                pg8::Gemm g{PL, WgT, M, D, 256, D, 256, 256}; pg8::StaticOrder S; S.init(M, D, G, (int)blockIdx.x);
                pg8::EpiBf16<0> E{MX, D, 0, 1.f};
                pg8::gemm_phase(lds, g, S, E);
            }
            GSYNC();
            {
                pg8::Gemm g{MX, PoT, M, D, D, D, D, 0}; pg8::StaticOrder S; S.init(M, D, G, (int)blockIdx.x);
                pg8::EpiResF32 E{XR, XR, D, p.p_scale};
                pg8::gemm_phase(lds, g, S, E);
            }
            GSYNC();
        }
        { LANE_INIT for (int mrow = gw; mrow < M; mrow += NGW) rms_row_bf16(XR + (size_t)mrow * D, p.mlp_g + (size_t)layer * D, U + (size_t)mrow * D, lane); }
        GSYNC();
        {
            pg8::Gemm g{U, W1T + (size_t)layer * D * FF, M, FF, D, D, D, 0}; pg8::StaticOrder S; S.init(M, FF, G, (int)blockIdx.x);
            pg8::EpiBf16<2> E{H1, FF, 0, 1.f};
            pg8::gemm_phase(lds, g, S, E);
        }
        GSYNC();
        {
            pg8::Gemm g{H1, W2T + (size_t)layer * D * FF, M, D, FF, FF, FF, 0}; pg8::StaticOrder S; S.init(M, D, G, (int)blockIdx.x);
            pg8::EpiResF32 E{XR, XR, D, nullptr};
            pg8::gemm_phase(lds, g, S, E);
        }
        GSYNC();
    }
    { LANE_INIT for (int mrow = gw; mrow < M; mrow += NGW) rms_row_f32(XR + (size_t)mrow * D, p.fin_g, p.out + (size_t)mrow * D, lane); }
}

extern "C" void kernel_launch(void* const* d_in, const int* in_sizes, int n_in, void* d_out, int out_size, void* d_ws, size_t ws_size, hipStream_t stream) {
    static int grid_blocks = 0;
    if (grid_blocks == 0) {
        int dev = 0, cus = 0, per_cu = 0;
        hipGetDevice(&dev);
        hipDeviceGetAttribute(&cus, hipDeviceAttributeMultiprocessorCount, dev);
        hipFuncSetAttribute((const void*)fwd_kernel, hipFuncAttributeMaxDynamicSharedMemorySize, LDS_BYTES);
        hipOccupancyMaxActiveBlocksPerMultiprocessor(&per_cu, (const void*)fwd_kernel, 512, LDS_BYTES);
        if (per_cu < 1) per_cu = 1;
        if (per_cu > 1) per_cu = 1;
        grid_blocks = cus * per_cu;
        if (ws_size < WS_END) { fprintf(stderr, "kernel_launch: workspace too small (%zu < %zu)\n", ws_size, (size_t)WS_END); grid_blocks = -1; }
    }
    if (grid_blocks < 0) return;
    Params p{};
    p.x = (const float*)d_in[0]; p.mix_g = (const float*)d_in[1]; p.mlp_g = (const float*)d_in[2]; p.w_in = (const float*)d_in[3]; p.gate_b = (const float*)d_in[4];
    p.head_g = (const float*)d_in[5]; p.w_out = (const float*)d_in[6]; p.pw_in = (const float*)d_in[7]; p.pw_group = (const float*)d_in[8]; p.pw_out = (const float*)d_in[9];
    p.p_scale = (const float*)d_in[10]; p.w1 = (const float*)d_in[11]; p.w2 = (const float*)d_in[12]; p.fin_g = (const float*)d_in[13];
    p.out = (float*)d_out; p.ws = (unsigned char*)d_ws;
    if (hipMemsetAsync(d_ws, 0, 65536, stream) != hipSuccess) { fprintf(stderr, "kernel_launch: memset of the barrier words failed\n"); return; }
    void* args[] = {&p};
    hipError_t e = hipLaunchCooperativeKernel((const void*)fwd_kernel, dim3(grid_blocks), dim3(512), args, LDS_BYTES, stream);
    if (e != hipSuccess) fprintf(stderr, "cooperative launch failed: %s (grid %d)\n", hipGetErrorString(e), grid_blocks);
}
```

```cpp
#include <hip/hip_runtime.h>
#include <hip/hip_cooperative_groups.h>
#include <cstdio>
#include <cstdint>
namespace cg = cooperative_groups;
#ifndef EXP
#define EXP 0
#endif

#define LAS __attribute__((address_space(3)))
typedef unsigned short bf16_t;
typedef short bf16x8 __attribute__((ext_vector_type(8)));
typedef float f32x4 __attribute__((ext_vector_type(4)));
typedef unsigned u32x4 __attribute__((ext_vector_type(4)));
typedef unsigned u32x2 __attribute__((ext_vector_type(2)));

constexpr int D = 1024, BATCH = 8, SEQ = 2048, M = BATCH * SEQ, NH = 8, DK = 64, DV = 128, FF = 4096;
constexpr int NIN = 3104, NQKVO = 3072;
constexpr float EPS = 1e-6f, SOFTCAP = 15.0f;

constexpr size_t MiB = 1u << 20;
constexpr size_t WS_WIN = 2 * MiB, WS_WO = 9 * MiB, WS_PIN = 11 * MiB, WS_WG = 13 * MiB, WS_PO = 14 * MiB;
constexpr size_t WS_W1 = 16 * MiB  , WS_W2 = 32 * MiB  ;
constexpr size_t WS_U = 48 * MiB;
constexpr size_t WS_BIG = 80 * MiB;
constexpr size_t WS_QKVO = WS_BIG;
constexpr size_t WS_G = WS_BIG + 96 * MiB;
constexpr size_t WS_HB = WS_BIG + 98 * MiB;
constexpr size_t WS_H1 = WS_BIG;
constexpr size_t WS_PA = WS_BIG, WS_PL = WS_BIG + 32 * MiB, WS_MX = WS_BIG + 64 * MiB;
constexpr size_t WS_XB = WS_BIG + 128 * MiB;
constexpr size_t WS_WC = WS_PIN - 0;
constexpr size_t WS_WGB = WS_WG;
constexpr size_t WS_WCT = 242 * MiB;
constexpr size_t WS_SS = 65536;
constexpr size_t WS_END = 244 * MiB;

__device__ __forceinline__ unsigned cvt_pk_bf16(float lo, float hi) { unsigned r; asm("v_cvt_pk_bf16_f32 %0, %1, %2" : "=v"(r) : "v"(lo), "v"(hi)); return r; }
__device__ __forceinline__ float bf_lo(unsigned u) { return __uint_as_float(u << 16); }
__device__ __forceinline__ float bf_hi(unsigned u) { return __uint_as_float(u & 0xffff0000u); }

namespace pg8 {
constexpr int BM = 256, BK = 64, HALF = 128, HTB = HALF * BK * 2, STAGE_BYTES = 8 * HTB, NXCD = 8, WGM = 8;
__host__ __device__ __forceinline__ int lds_byte(int r, int c) { const int st = (r >> 4) * 2 + (c >> 5), rr = r & 15, cc = c & 31, ob = rr * 64 + cc * 2; return st * 1024 + (ob ^ (((ob >> 9) & 1) << 5)); }
__host__ __device__ __forceinline__ void stage_rc(int b, int& R, int& C) { const int st = b / 1024, sb = b % 1024, swz = sb ^ (((sb >> 9) & 1) << 5); R = (st >> 1) * 16 + swz / 64; C = (st & 1) * 32 + (swz % 64) / 2; }
__host__ __device__ __forceinline__ int perm32(int rho) { const int n = rho >> 4, i = rho & 15; return 8 * (i >> 2) + 4 * n + (i & 3); }

struct Unit { int pm, pn; };
struct Gemm { const bf16_t* A; const bf16_t* Bt; int M, N, K, lda, ldb, acol; };

struct StaticOrder {
    int nM, nN, nwg, G, c;
    __host__ __device__ void init(int M_, int N_, int G_, int c_) { nM = M_ / BM; nN = N_ / BM; nwg = nM * nN; G = G_; c = c_; }
    __host__ __device__ bool next(int i, Unit& u) const {
        const long L = (long)i * G + c; if (L >= nwg) return false;
        int wgid = (int)L; { const int q = nwg / NXCD, r = nwg % NXCD, xcd = wgid % NXCD, off = wgid / NXCD; wgid = (xcd < r ? xcd * (q + 1) : r * (q + 1) + (xcd - r) * q) + off; }
        const int nig = WGM * nN, gid = wgid / nig, fm = gid * WGM, gsz = (nM - fm) < WGM ? (nM - fm) : WGM;
        u.pm = fm + ((wgid % nig) % gsz); u.pn = (wgid % nig) / gsz; return true;
    }
};

template <int ACT  > struct EpiBf16 {
    static constexpr bool PERM = true;
    bf16_t* O; int ldc; int qtiles; float qscale;
    const float* ss;
    __device__ __forceinline__ void operator()(const f32x4 (&acc)[2][2][4][2], const Unit& u, int wr, int wc, int fr, int fq) const {
        const int row0 = u.pm * BM + wr * 64 + fr; const int col0 = u.pn * BM + wc * 32 + 8 * fq;
        const float sc0 = (u.pn < qtiles) ? qscale : 1.f;
#pragma unroll
        for (int ai = 0; ai < 2; ++ai)
#pragma unroll
            for (int m = 0; m < 4; ++m) { bf16_t* rowp = O + (size_t)(row0 + ai * HALF + m * 16) * ldc + col0;
                const float sc = ss ? sc0 / sqrtf(ss[row0 + ai * HALF + m * 16] * (1.f / 1024.f) + 1e-6f) : sc0;
#pragma unroll
                for (int bj = 0; bj < 2; ++bj) { f32x4 v0 = acc[ai][bj][m][0] * sc, v1 = acc[ai][bj][m][1] * sc;
                    if (ACT == 2) {
#pragma unroll
                        for (int e = 0; e < 4; ++e) { float a = fmaxf(v0[e], 0.f); v0[e] = a * a; float b = fmaxf(v1[e], 0.f); v1[e] = b * b; } }
                    u32x4 w; w.x = cvt_pk_bf16(v0[0], v0[1]); w.y = cvt_pk_bf16(v0[2], v0[3]); w.z = cvt_pk_bf16(v1[0], v1[1]); w.w = cvt_pk_bf16(v1[2], v1[3]);
                    *(u32x4*)(rowp + bj * HALF) = w; } }
    }
};
struct EpiResF32 {
    static constexpr bool PERM = false;
    const float* base; float* out; int ldc; const float* cscale;
    bf16_t* xb; float* ss;
    __device__ __forceinline__ void operator()(const f32x4 (&acc)[2][2][4][2], const Unit& u, int wr, int wc, int fr, int fq) const {
        const int col0 = u.pn * BM + wc * 32 + 4 * fq;
        f32x4 cs[2][2];
#pragma unroll
        for (int bj = 0; bj < 2; ++bj)
#pragma unroll
            for (int n = 0; n < 2; ++n) cs[bj][n] = cscale ? *(const f32x4*)(cscale + col0 + bj * HALF + n * 16) : (f32x4){1.f, 1.f, 1.f, 1.f};
#pragma unroll
        for (int ai = 0; ai < 2; ++ai)
#pragma unroll
            for (int m = 0; m < 4; ++m) { const size_t off = (size_t)(u.pm * BM + ai * HALF + wr * 64 + m * 16 + fr) * ldc + col0; float q = 0.f;
#pragma unroll
                for (int bj = 0; bj < 2; ++bj)
#pragma unroll
                    for (int n = 0; n < 2; ++n) { const f32x4 bs = *(const f32x4*)(base + off + bj * HALF + n * 16); const f32x4 o = bs + acc[ai][bj][m][n] * cs[bj][n];
                        *(f32x4*)(out + off + bj * HALF + n * 16) = o;
                        if (xb) { u32x2 w; w.x = cvt_pk_bf16(o[0], o[1]); w.y = cvt_pk_bf16(o[2], o[3]); *(u32x2*)(xb + off + bj * HALF + n * 16) = w; }
                        q += (o[0] * o[0] + o[1] * o[1]) + (o[2] * o[2] + o[3] * o[3]); }
                if (ss) { q += __shfl_xor(q, 16); q += __shfl_xor(q, 32);
                    if (fq == 0) (void)__hip_atomic_fetch_add(ss + (u.pm * BM + ai * HALF + wr * 64 + m * 16 + fr), q, __ATOMIC_RELAXED, __HIP_MEMORY_SCOPE_AGENT); } }
    }
};

template <class Epi>
__device__ __forceinline__ void gemm_phase(LAS unsigned char* lds, const Gemm g, const StaticOrder& S, const Epi& E) {
    int tid_ = threadIdx.x; asm volatile("" : "+v"(tid_));
    const int tid = tid_, wid = __builtin_amdgcn_readfirstlane(tid >> 6), lane = tid & 63, wr = wid >> 2, wc = wid & 3, fr = lane & 15, fq = lane >> 4;
    const int nt = g.K / BK;
    unsigned voffA[2], voffB[2];
#pragma unroll
    for (int i = 0; i < 2; ++i) { int R, C; stage_rc(tid * 16 + i * 8192, R, C); const int Rb = Epi::PERM ? ((R & ~31) + perm32(R & 31)) : R;
        voffA[i] = (unsigned)(R * g.lda + C) * 2u; voffB[i] = (unsigned)(Rb * g.ldb + C) * 2u; }
    const size_t kstep = (size_t)(BK * 2);
    const size_t hstepA = (size_t)HALF * g.lda * 2, hstepB = (size_t)HALF * g.ldb * 2;
    const size_t tstepA = 2 * hstepA, tstepB = 2 * hstepB;
    const unsigned ldsw = (unsigned)wid * 1024u;
    const int aoff = lds_byte(wr * 64 + fr, fq * 8), boff = lds_byte(wc * 32 + fr, fq * 8);
#define PG8_SA(b, h) (((b) * 2 + (h)) * HTB)
#define PG8_SB(b, h) ((4 + (b) * 2 + (h)) * HTB)
#define PG8_STAGE(bufoff, gbase, voff) do { _Pragma("unroll") for (int _i = 0; _i < 2; ++_i) \
        __builtin_amdgcn_global_load_lds((const unsigned*)((const char*)(gbase) + (voff)[_i]), (LAS unsigned*)(lds + (bufoff) + ldsw + _i * 8192), 16, 0, 0); } while (0)
#define PG8_LDA(dst, b, h) do { _Pragma("unroll") for (int m = 0; m < 4; ++m) _Pragma("unroll") for (int k = 0; k < 2; ++k) dst[m][k] = *(const LAS bf16x8*)(lds + PG8_SA(b, h) + aoff + m * 2048 + k * 1024); } while (0)
#define PG8_LDB(dst, b, h) do { _Pragma("unroll") for (int n = 0; n < 2; ++n) _Pragma("unroll") for (int k = 0; k < 2; ++k) dst[n][k] = *(const LAS bf16x8*)(lds + PG8_SB(b, h) + boff + n * 2048 + k * 1024); } while (0)
#define PG8_MMA(ai, bj, At, Bt) do { __builtin_amdgcn_s_setprio(1); _Pragma("unroll") for (int m = 0; m < 4; ++m) _Pragma("unroll") for (int n = 0; n < 2; ++n) _Pragma("unroll") for (int k = 0; k < 2; ++k) \
        acc[ai][bj][m][n] = __builtin_amdgcn_mfma_f32_16x16x32_bf16(Bt[n][k], At[m][k], acc[ai][bj][m][n], 0, 0, 0); __builtin_amdgcn_s_setprio(0); } while (0)
#define PG8_WAIT_V(n) asm volatile("s_waitcnt vmcnt(" #n ")" ::: "memory")
#define PG8_WAIT_L(n) asm volatile("s_waitcnt lgkmcnt(" #n ")" ::: "memory")
#define PG8_BAR __builtin_amdgcn_s_barrier()
#define PG8_SCHED __builtin_amdgcn_sched_barrier(0)
    Unit cur, nxt; int ui = 0;
    if (!S.next(0, cur)) return;
    f32x4 acc[2][2][4][2];
#pragma unroll
    for (int a = 0; a < 2; ++a)
#pragma unroll
        for (int b = 0; b < 2; ++b)
#pragma unroll
            for (int m = 0; m < 4; ++m)
#pragma unroll
                for (int n = 0; n < 2; ++n) acc[a][b][m][n] = (f32x4){0.f, 0.f, 0.f, 0.f};
    bf16x8 At[4][2], B0[2][2], B1[2][2];
    const char* cA = (const char*)g.A + (size_t)cur.pm * tstepA + (size_t)cur.pn * g.acol * 2; const char* cB = (const char*)g.Bt + (size_t)cur.pn * tstepB;
    PG8_STAGE(PG8_SB(0, 0), cB, voffB); PG8_STAGE(PG8_SB(0, 1), cB + hstepB, voffB); PG8_STAGE(PG8_SA(0, 0), cA, voffA); PG8_STAGE(PG8_SA(0, 1), cA + hstepA, voffA);
    if (wr == 1) PG8_BAR;
    PG8_WAIT_V(2); PG8_BAR;
    PG8_STAGE(PG8_SB(1, 0), cB + kstep, voffB); PG8_STAGE(PG8_SA(1, 0), cA + kstep, voffA); PG8_STAGE(PG8_SB(1, 1), cB + hstepB + kstep, voffB);
    PG8_WAIT_V(6); PG8_BAR;
    for (;;) {
        const bool has_next = S.next(ui + 1, nxt);
        const char* nA = has_next ? (const char*)g.A + (size_t)nxt.pm * tstepA + (size_t)nxt.pn * g.acol * 2 : cA; const char* nB = has_next ? (const char*)g.Bt + (size_t)nxt.pn * tstepB : cB;
        for (int t = 0; t < nt; t += 2) {
            const bool last = (t == nt - 2);
            const char* a1 = cA + (size_t)(t + 1) * kstep;
            const char* a2 = last ? nA : cA + (size_t)(t + 2) * kstep; const char* b2 = last ? nB : cB + (size_t)(t + 2) * kstep;
            const char* a3 = a2 + kstep; const char* b3 = b2 + kstep;
            PG8_LDB(B0, 0, 0); PG8_LDB(B1, 0, 1); PG8_SCHED; PG8_LDA(At, 0, 0); PG8_STAGE(PG8_SA(1, 1), a1 + hstepA, voffA);
            PG8_WAIT_V(8); PG8_WAIT_L(0); PG8_BAR; PG8_MMA(0, 0, At, B0); PG8_MMA(0, 1, At, B1); PG8_BAR; PG8_SCHED;
            PG8_LDA(At, 0, 1); PG8_STAGE(PG8_SB(0, 0), b2, voffB); PG8_STAGE(PG8_SB(0, 1), b2 + hstepB, voffB); PG8_STAGE(PG8_SA(0, 0), a2, voffA);
            PG8_WAIT_V(8); PG8_WAIT_L(0); PG8_BAR; PG8_MMA(1, 0, At, B0); PG8_MMA(1, 1, At, B1); PG8_BAR; PG8_SCHED;
            PG8_LDB(B0, 1, 0); PG8_LDB(B1, 1, 1); PG8_SCHED; PG8_LDA(At, 1, 0); PG8_STAGE(PG8_SA(0, 1), a2 + hstepA, voffA);
            PG8_WAIT_V(8); PG8_WAIT_L(0); PG8_BAR; PG8_MMA(0, 0, At, B0); PG8_MMA(0, 1, At, B1); PG8_BAR; PG8_SCHED;
            PG8_LDA(At, 1, 1); PG8_STAGE(PG8_SB(1, 0), b3, voffB); PG8_STAGE(PG8_SB(1, 1), b3 + hstepB, voffB); PG8_STAGE(PG8_SA(1, 0), a3, voffA);
            PG8_WAIT_V(8); PG8_WAIT_L(0); PG8_BAR; PG8_MMA(1, 0, At, B0); PG8_MMA(1, 1, At, B1); PG8_BAR; PG8_SCHED;
        }
        if (wr == 0) PG8_BAR;
        E(acc, cur, wr, wc, fr, fq);
        if (!has_next) break;
#pragma unroll
        for (int a = 0; a < 2; ++a)
#pragma unroll
            for (int b = 0; b < 2; ++b)
#pragma unroll
                for (int m = 0; m < 4; ++m)
#pragma unroll
                    for (int n = 0; n < 2; ++n) acc[a][b][m][n] = (f32x4){0.f, 0.f, 0.f, 0.f};
        cur = nxt; cA = nA; cB = nB; ++ui;
        if (wr == 1) PG8_BAR;
    }
    PG8_WAIT_V(0);
    PG8_BAR;
#undef PG8_SA
#undef PG8_SB
#undef PG8_STAGE
#undef PG8_LDA
#undef PG8_LDB
#undef PG8_MMA
#undef PG8_WAIT_V
#undef PG8_WAIT_L
#undef PG8_BAR
#undef PG8_SCHED
}
}


#define XB_TMO      128
#define XB_XCNT(j)  (256  + 64 * (j))
#define XB_XSUB(j)  (1280 + 64 * (j))
#define XB_XGEN(j)  (2304 + 64 * (j))
#define XB_TOP      3328
#define XB_TOPGEN   3392
#define XCD_BAR_WORDS 3456
#define XB_SPIN_CAP (1u << 18)
__device__ __forceinline__ unsigned xb_ld(unsigned* p)              { return __hip_atomic_load(p, __ATOMIC_RELAXED, __HIP_MEMORY_SCOPE_AGENT); }
__device__ __forceinline__ unsigned xb_add(unsigned* p, unsigned v) { return __hip_atomic_fetch_add(p, v, __ATOMIC_RELAXED, __HIP_MEMORY_SCOPE_AGENT); }
__device__ __forceinline__ unsigned xb_xcc_id() { return (unsigned)__builtin_amdgcn_s_getreg((3 << 11) | 20) & 0xFu; }
#define XB_SPIN(cond, bar) do { unsigned _sp = 0; while (cond) { __builtin_amdgcn_s_sleep(1); \
    if ((++_sp & 255u) == 0u) { if (xb_ld(&(bar)[XB_TMO])) break; if (_sp > XB_SPIN_CAP) { atomicAdd(&(bar)[XB_TMO], 1u); break; } } } } while (0)
struct XcdBarrier { unsigned* bar; unsigned x; volatile LAS unsigned* st; };
__device__ __forceinline__ XcdBarrier xcd_barrier_post(unsigned* bar, volatile LAS unsigned* st) {
    XcdBarrier b; b.bar = bar; b.x = xb_xcc_id(); b.st = st;
    if (threadIdx.x == 0) (void)xb_add(&bar[XB_XCNT(b.x)], 1u);
    return b;
}
__device__ __forceinline__ void xcd_barrier_complete(unsigned* bar, unsigned x, unsigned& nloc, unsigned& nx) {
    const unsigned G = gridDim.x * gridDim.y * gridDim.z;
    unsigned sum, cnt, mine, sp = 0u;
    for (;;) {
        sum = 0u; cnt = 0u; mine = 0u;
#pragma unroll
        for (unsigned j = 0; j < 16; ++j) { const unsigned c = xb_ld(&bar[XB_XCNT(j)]); sum += c; cnt += (c > 0u) ? 1u : 0u; mine = (j == x) ? c : mine; }
        if (sum == G) break;
        __builtin_amdgcn_s_sleep(1);
        if ((++sp & 255u) == 0u) { if (xb_ld(&bar[XB_TMO])) break; if (sp > XB_SPIN_CAP) { atomicAdd(&bar[XB_TMO], 1u); break; } }
    }
    nloc = mine > 0u ? mine : 1u; nx = cnt > 0u ? cnt : 1u;
}
__device__ __forceinline__ void xcd_barrier(unsigned* const bbar, volatile LAS unsigned* const bst) {
    asm volatile("s_waitcnt vmcnt(0)" ::: "memory");
    __syncthreads();
    if (threadIdx.x == 0) {
        unsigned* bar = bbar; const unsigned bx = xb_xcc_id();
        __builtin_amdgcn_s_waitcnt(0);
        unsigned nloc = bst[0], nx = bst[1];
        if (nloc == 0u) { xcd_barrier_complete(bar, bx, nloc, nx); bst[0] = nloc; bst[1] = nx; }
        const unsigned old = xb_add(&bar[XB_XSUB(bx)], 1u);
        const unsigned gen = old / nloc;
        if (old + 1u == (gen + 1u) * nloc) {
            __builtin_amdgcn_fence(__ATOMIC_RELEASE, "agent");
            asm volatile("s_waitcnt vmcnt(0)" ::: "memory");
            const unsigned og = xb_add(&bar[XB_TOP], 1u);
            const unsigned tg = og / nx;
            if (og + 1u == (tg + 1u) * nx) xb_add(&bar[XB_TOPGEN], 1u);
            else XB_SPIN(xb_ld(&bar[XB_TOPGEN]) == tg, bar);
            __builtin_amdgcn_fence(__ATOMIC_ACQUIRE, "agent");
            xb_add(&bar[XB_XGEN(bx)], 1u);
            asm volatile("s_waitcnt vmcnt(0)" ::: "memory");
        } else {
            XB_SPIN(xb_ld(&bar[XB_XGEN(bx)]) == gen, bar);
            __builtin_amdgcn_fence(__ATOMIC_ACQUIRE, "agent");
            asm volatile("s_waitcnt vmcnt(0)" ::: "memory");
        }
    }
    __syncthreads();
}

__device__ __forceinline__ float wave_sum(float v) {
#pragma unroll
    for (int o = 1; o < 64; o <<= 1) v += __shfl_xor(v, o);
    return v;
}
__device__ __forceinline__ float wave_incl_sum(float v, int lane) {
#pragma unroll
    for (int o = 1; o < 64; o <<= 1) { const float t = __shfl_up(v, o); if (lane >= o) v += t; }
    return v;
}
__device__ __forceinline__ float wave_incl_max(float v, int lane) {
#pragma unroll
    for (int o = 1; o < 64; o <<= 1) { const float t = __shfl_up(v, o); if (lane >= o) v = fmaxf(v, t); }
    return v;
}

__device__ __forceinline__ void transpose_item(const float* W, int K, int N, bf16_t* WT, LAS float* scr, int item, int lane, const float* kgain = nullptr) {
    const int nblk = N / 32, kb = item / nblk, nb = item % nblk, k0 = 64 * kb, n0 = 32 * nb;
#pragma unroll
    for (int i = 0; i < 32; ++i) { const int kk = 2 * i + (lane >> 5); const float gk = kgain ? kgain[k0 + kk] : 1.f; scr[kk * 33 + (lane & 31)] = W[(size_t)(k0 + kk) * N + n0 + (lane & 31)] * gk; }
    asm volatile("s_waitcnt lgkmcnt(0)" ::: "memory");
    const int c = lane & 7;
#pragma unroll
    for (int j = 0; j < 4; ++j) { const int n = (lane >> 3) + 8 * j; const LAS float* s = scr + (8 * c) * 33 + n;
        u32x4 o; o.x = cvt_pk_bf16(s[0 * 33], s[1 * 33]); o.y = cvt_pk_bf16(s[2 * 33], s[3 * 33]); o.z = cvt_pk_bf16(s[4 * 33], s[5 * 33]); o.w = cvt_pk_bf16(s[6 * 33], s[7 * 33]);
        *(u32x4*)(WT + (size_t)(n0 + n) * K + k0 + 8 * c) = o; }
    asm volatile("s_waitcnt lgkmcnt(0)" ::: "memory");
}

__device__ __forceinline__ void rms_row_bf16(const float* xrow, const float* g, bf16_t* orow, int lane) {
    const f32x4* xr = (const f32x4*)xrow + lane; const f32x4* gr = (const f32x4*)g + lane;
    f32x4 v[4]; float s = 0.f;
#pragma unroll
    for (int j = 0; j < 4; ++j) { v[j] = xr[64 * j]; s += (v[j].x * v[j].x + v[j].y * v[j].y) + (v[j].z * v[j].z + v[j].w * v[j].w); }
    const float r = 1.0f / sqrtf(wave_sum(s) * (1.f / D) + EPS);
    u32x2* o8 = (u32x2*)orow + lane;
#pragma unroll
    for (int j = 0; j < 4; ++j) { const f32x4 gg = gr[64 * j]; u32x2 w; w.x = cvt_pk_bf16(v[j].x * r * gg.x, v[j].y * r * gg.y); w.y = cvt_pk_bf16(v[j].z * r * gg.z, v[j].w * r * gg.w); o8[64 * j] = w; }
}
__device__ __forceinline__ void rms_row_f32(const float* xrow, const float* g, float* orow, int lane) {
    const f32x4* xr = (const f32x4*)xrow + lane; const f32x4* gr = (const f32x4*)g + lane;
    f32x4 v[4]; float s = 0.f;
#pragma unroll
    for (int j = 0; j < 4; ++j) { v[j] = xr[64 * j]; s += (v[j].x * v[j].x + v[j].y * v[j].y) + (v[j].z * v[j].z + v[j].w * v[j].w); }
    const float r = 1.0f / sqrtf(wave_sum(s) * (1.f / D) + EPS);
    f32x4* o = (f32x4*)orow + lane;
#pragma unroll
    for (int j = 0; j < 4; ++j) { const f32x4 gg = gr[64 * j]; o[64 * j] = v[j] * r * gg; }
}


template <int W, int T> __device__ __forceinline__ void pool_run(const bf16_t* src, bf16_t* dst, int t0) {
    constexpr int H = W / 2, NR = T + W - 1;
    u32x4 r[NR];
    const bf16_t* p0 = src + ((long)t0 - H) * D;
#pragma unroll
    for (int k = 0; k < NR; ++k) r[k] = *(const u32x4*)(p0 + (size_t)k * D);
#pragma unroll
    for (int k = 0; k < NR; ++k) { const int t = t0 - H + k; if (k < H || k >= T + H) { const bool ok = (t >= 0) && (t < SEQ); r[k] = ok ? r[k] : (u32x4){0u, 0u, 0u, 0u}; } }
    float s[8];
#pragma unroll
    for (int e = 0; e < 8; ++e) s[e] = 0.f;
#pragma unroll
    for (int k = 0; k < W; ++k) { s[0] += bf_lo(r[k].x); s[1] += bf_hi(r[k].x); s[2] += bf_lo(r[k].y); s[3] += bf_hi(r[k].y); s[4] += bf_lo(r[k].z); s[5] += bf_hi(r[k].z); s[6] += bf_lo(r[k].w); s[7] += bf_hi(r[k].w); }
#pragma unroll
    for (int i = 0; i < T; ++i) {
        const int t = t0 + i; const int lo = max(t - H, 0), hi = min(t + H, SEQ); const float ic = 1.0f / (float)(hi - lo);
        const u32x4 v = r[i + H]; u32x4 o;
        o.x = cvt_pk_bf16(s[0] * ic - bf_lo(v.x), s[1] * ic - bf_hi(v.x)); o.y = cvt_pk_bf16(s[2] * ic - bf_lo(v.y), s[3] * ic - bf_hi(v.y));
        o.z = cvt_pk_bf16(s[4] * ic - bf_lo(v.z), s[5] * ic - bf_hi(v.z)); o.w = cvt_pk_bf16(s[6] * ic - bf_lo(v.w), s[7] * ic - bf_hi(v.w));
        *(u32x4*)(dst + (size_t)t * D) = o;
        if (i + 1 < T) { const u32x4 a = r[i + W], d = r[i];
            s[0] += bf_lo(a.x) - bf_lo(d.x); s[1] += bf_hi(a.x) - bf_hi(d.x); s[2] += bf_lo(a.y) - bf_lo(d.y); s[3] += bf_hi(a.y) - bf_hi(d.y);
            s[4] += bf_lo(a.z) - bf_lo(d.z); s[5] += bf_hi(a.z) - bf_hi(d.z); s[6] += bf_lo(a.w) - bf_lo(d.w); s[7] += bf_hi(a.w) - bf_hi(d.w); }
    }
}

constexpr int LS = 72;
constexpr int ML_Q = 0, ML_K = 9216, ML_KWT = 18432, ML_VT = 27648, ML_CT = 39168, ML_END = 50688;

__device__ __forceinline__ void mlstm_phase(LAS unsigned char* lds, const bf16_t* QKVO, const float* Gt, float* HF, float* HB, int tid, int lane, int wave) {
    const int fr = lane & 15, fq = lane >> 4, tt = wave & 3, vs = wave >> 2;
    LAS bf16_t* Qs = (LAS bf16_t*)(lds + ML_Q); LAS bf16_t* Ks = (LAS bf16_t*)(lds + ML_K); LAS bf16_t* KwT = (LAS bf16_t*)(lds + ML_KWT);
    LAS bf16_t* VT = (LAS bf16_t*)(lds + ML_VT); LAS bf16_t* CT = (LAS bf16_t*)(lds + ML_CT);
    for (int item = blockIdx.x; item < 256; item += gridDim.x) {
        const int vh = item & 1, dir = (item >> 1) & 1, h = (item >> 2) & 7, b = item >> 5;
        const bf16_t* qb = QKVO + (size_t)b * SEQ * NQKVO + h * DK + 8 * wave;
        const bf16_t* kb = qb + 512;
        const bf16_t* vb = QKVO + (size_t)b * SEQ * NQKVO + 1024 + h * DV + vh * 64 + 8 * wave;
        const float* gi = Gt + (size_t)b * SEQ * 32 + (2 * dir) * 8 + h; const float* gf = gi + 8;
        float* Hout = (dir ? HB : HF) + (size_t)b * SEQ * D + h * DV + vh * 64;
        __syncthreads();
        for (int idx = tid; idx < 16 * 64; idx += 512) { const int r = 64 + (idx >> 6), c = idx & 63; VT[r * LS + c] = (r == 64) ? (bf16_t)0x3F80 : (bf16_t)0; }
        f32x4 accC[3];
#pragma unroll
        for (int i = 0; i < 3; ++i) accC[i] = (f32x4){0.f, 0.f, 0.f, 0.f};
        float m = 0.f;
        int pos = dir ? (SEQ - 1 - lane) : lane;
        u32x4 q16 = *(const u32x4*)(qb + (size_t)pos * NQKVO), k16 = *(const u32x4*)(kb + (size_t)pos * NQKVO), v16 = *(const u32x4*)(vb + (size_t)pos * NQKVO);
        float li = gi[(size_t)pos * 32], lf = gf[(size_t)pos * 32];
        for (int j = 0; j < SEQ / 64; ++j) {
            const float bcs = wave_incl_sum(lf, lane);
            const float a = li - bcs;
            const float cm = wave_incl_max(a, lane);
            const float Mv = fmaxf(m, cm);
            const float b_last = __shfl(bcs, 63), M63 = __shfl(Mv, 63);
            const float decay = __expf(m - M63);
            const float wk = __expf(a - M63);
            *(LAS u32x4*)(Qs + lane * LS + 8 * wave) = q16;
            *(LAS u32x4*)(Ks + lane * LS + 8 * wave) = k16;
            {
                const unsigned kk[4] = {k16.x, k16.y, k16.z, k16.w}, vv[4] = {v16.x, v16.y, v16.z, v16.w};
#pragma unroll
                for (int e = 0; e < 4; ++e) {
                    const unsigned kw = cvt_pk_bf16(bf_lo(kk[e]) * wk, bf_hi(kk[e]) * wk);
                    KwT[(8 * wave + 2 * e) * LS + lane] = (bf16_t)(kw & 0xffffu); KwT[(8 * wave + 2 * e + 1) * LS + lane] = (bf16_t)(kw >> 16);
                    VT[(8 * wave + 2 * e) * LS + lane] = (bf16_t)(vv[e] & 0xffffu); VT[(8 * wave + 2 * e + 1) * LS + lane] = (bf16_t)(vv[e] >> 16);
                }
            }
            {
                const int nvt = vs ? 2 : 3, vt0 = vs ? 3 : 0;
#pragma unroll
                for (int vi = 0; vi < 3; ++vi) if (vi < nvt) {
                    u32x2 w; w.x = cvt_pk_bf16(accC[vi][0], accC[vi][1]); w.y = cvt_pk_bf16(accC[vi][2], accC[vi][3]);
                    *(LAS u32x2*)(CT + (16 * (vt0 + vi) + fr) * LS + 16 * tt + 4 * fq) = w; }
            }
            __syncthreads();
            u32x4 q16n = q16, k16n = k16, v16n = v16; float lin = li, lfn = lf;
            if (j + 1 < SEQ / 64) {
                const int pn = dir ? (SEQ - 1 - (64 * (j + 1) + lane)) : (64 * (j + 1) + lane);
                q16n = *(const u32x4*)(qb + (size_t)pn * NQKVO); k16n = *(const u32x4*)(kb + (size_t)pn * NQKVO); v16n = *(const u32x4*)(vb + (size_t)pn * NQKVO);
                lin = gi[(size_t)pn * 32]; lfn = gf[(size_t)pn * 32];
            }
            bf16x8 qf[2];
            qf[0] = *(const LAS bf16x8*)(Qs + (16 * tt + fr) * LS + 8 * fq); qf[1] = *(const LAS bf16x8*)(Qs + (16 * tt + fr) * LS + 32 + 8 * fq);
            const float Mt = __shfl(Mv, 16 * tt + fr), bt = __shfl(bcs, 16 * tt + fr);
            float p[4][4];
#pragma unroll
            for (int st = 0; st < 4; ++st) {
                f32x4 s4 = (f32x4){0.f, 0.f, 0.f, 0.f};
                if (st <= tt) {
                    const bf16x8 kf0 = *(const LAS bf16x8*)(Ks + (16 * st + fr) * LS + 8 * fq), kf1 = *(const LAS bf16x8*)(Ks + (16 * st + fr) * LS + 32 + 8 * fq);
                    s4 = __builtin_amdgcn_mfma_f32_16x16x32_bf16(kf0, qf[0], s4, 0, 0, 0);
                    s4 = __builtin_amdgcn_mfma_f32_16x16x32_bf16(kf1, qf[1], s4, 0, 0, 0);
                }
#pragma unroll
                for (int i = 0; i < 4; ++i) {
                    const int sidx = 16 * st + 4 * fq + i;
                    const float as = __shfl(a, sidx);
                    const float w = (sidx <= 16 * tt + fr) ? __expf(as - Mt) : 0.f;
                    p[st][i] = s4[i] * w;
                }
            }
            bf16x8 pb[2];
#pragma unroll
            for (int kk2 = 0; kk2 < 2; ++kk2) {
                u32x4 w; w.x = cvt_pk_bf16(p[2 * kk2][0], p[2 * kk2][1]); w.y = cvt_pk_bf16(p[2 * kk2][2], p[2 * kk2][3]);
                w.z = cvt_pk_bf16(p[2 * kk2 + 1][0], p[2 * kk2 + 1][1]); w.w = cvt_pk_bf16(p[2 * kk2 + 1][2], p[2 * kk2 + 1][3]);
                pb[kk2] = __builtin_bit_cast(bf16x8, w);
            }
            const float sc = __expf(m - Mt);
            f32x4 num[3];
#pragma unroll
            for (int vi = 0; vi < 3; ++vi) {
                const int vt = (vi < 2) ? (2 * vs + vi) : 4;
                f32x4 a1 = (f32x4){0.f, 0.f, 0.f, 0.f}, a2 = (f32x4){0.f, 0.f, 0.f, 0.f};
#pragma unroll
                for (int kk2 = 0; kk2 < 2; ++kk2) {
                    const u32x2 lo = *(const LAS u32x2*)(VT + (16 * vt + fr) * LS + 32 * kk2 + 4 * fq), hi = *(const LAS u32x2*)(VT + (16 * vt + fr) * LS + 32 * kk2 + 16 + 4 * fq);
                    const u32x4 vv = (u32x4){lo.x, lo.y, hi.x, hi.y};
                    a1 = __builtin_amdgcn_mfma_f32_16x16x32_bf16(__builtin_bit_cast(bf16x8, vv), pb[kk2], a1, 0, 0, 0);
                    const bf16x8 cf = *(const LAS bf16x8*)(CT + (16 * vt + fr) * LS + 32 * kk2 + 8 * fq);
                    a2 = __builtin_amdgcn_mfma_f32_16x16x32_bf16(cf, qf[kk2], a2, 0, 0, 0);
                }
                num[vi] = a1 + a2 * sc;
            }
            const float den = __shfl(num[2][0], fr);
            const float inv = 1.0f / fmaxf(fabsf(den), __expf(-(bt + Mt)));
            {
                const int tl = 64 * j + 16 * tt + fr; const int post = dir ? (SEQ - 1 - tl) : tl;
#pragma unroll
                for (int vi = 0; vi < 2; ++vi) *(f32x4*)(Hout + (size_t)post * D + 16 * (2 * vs + vi) + 4 * fq) = num[vi] * inv;
            }
            {
                const int nvt = vs ? 2 : 3, vt0 = vs ? 3 : 0;
                const bf16x8 kf0 = *(const LAS bf16x8*)(KwT + (16 * tt + fr) * LS + 8 * fq), kf1 = *(const LAS bf16x8*)(KwT + (16 * tt + fr) * LS + 32 + 8 * fq);
#pragma unroll
                for (int vi = 0; vi < 3; ++vi) if (vi < nvt) {
                    const bf16x8 vf0 = *(const LAS bf16x8*)(VT + (16 * (vt0 + vi) + fr) * LS + 8 * fq), vf1 = *(const LAS bf16x8*)(VT + (16 * (vt0 + vi) + fr) * LS + 32 + 8 * fq);
                    f32x4 c = accC[vi] * decay;
                    c = __builtin_amdgcn_mfma_f32_16x16x32_bf16(kf0, vf0, c, 0, 0, 0);
                    c = __builtin_amdgcn_mfma_f32_16x16x32_bf16(kf1, vf1, c, 0, 0, 0);
                    accC[vi] = c; }
            }
            m = b_last + M63;
            __syncthreads();
            q16 = q16n; k16 = k16n; v16 = v16n; li = lin; lf = lfn;
        }
    }
}

struct Params {
    const float* x; const float* mix_g; const float* mlp_g; const float* w_in; const float* gate_b; const float* head_g; const float* w_out;
    const float* pw_in; const float* pw_group; const float* pw_out; const float* p_scale; const float* w1; const float* w2; const float* fin_g;
    float* out; unsigned char* ws;
};
constexpr int LDS_BYTES = 147456;

__global__ void __launch_bounds__(512, 2) fwd_kernel(Params p) {
    extern __shared__ __attribute__((aligned(16))) unsigned char lds_raw[];
    LAS unsigned char* lds = (LAS unsigned char*)lds_raw;
    cg::grid_group grid = cg::this_grid();
    if (p.ws == nullptr) grid.sync();
    volatile LAS unsigned* MISC = (volatile LAS unsigned*)(lds + 131072 + 320);
    if (threadIdx.x < 32) MISC[threadIdx.x] = 0u;
    __syncthreads();
    if (threadIdx.x == 0) (void)xb_add((unsigned*)p.ws + 4096 + XB_XCNT(xb_xcc_id()), 1u);
#if EXP == 2
#define GSYNC() do { xcd_barrier((unsigned*)p.ws + 4096, MISC + 8); xcd_barrier((unsigned*)p.ws + 4096, MISC + 8); } while (0)
#else
#define GSYNC() xcd_barrier((unsigned*)p.ws + 4096, MISC + 8)
#endif
    const int G = gridDim.x, NGW = G * 8;
#define LANE_INIT int tid = threadIdx.x; asm volatile("" : "+v"(tid)); const int lane = tid & 63, wave = __builtin_amdgcn_readfirstlane(tid >> 6), gw = blockIdx.x * 8 + wave; (void)gw; (void)lane;
    unsigned char* ws = p.ws;
    bf16_t* WinT = (bf16_t*)(ws + WS_WIN); bf16_t* WoT = (bf16_t*)(ws + WS_WO); bf16_t* PinT = (bf16_t*)(ws + WS_PIN); bf16_t* WgB = (bf16_t*)(ws + WS_WGB); bf16_t* PoT = (bf16_t*)(ws + WS_PO);
    bf16_t* WcT = (bf16_t*)(ws + WS_WCT); bf16_t* W1T = (bf16_t*)(ws + WS_W1); bf16_t* W2T = (bf16_t*)(ws + WS_W2);
    bf16_t* U = (bf16_t*)(ws + WS_U); bf16_t* XB = (bf16_t*)(ws + WS_XB); bf16_t* QKVO = (bf16_t*)(ws + WS_QKVO); float* Gt = (float*)(ws + WS_G); float* HB = (float*)(ws + WS_HB); float* HF = p.out;
    bf16_t* H1 = (bf16_t*)(ws + WS_H1); bf16_t* PA = (bf16_t*)(ws + WS_PA); bf16_t* PL = (bf16_t*)(ws + WS_PL);
    float* SS = (float*)(ws + WS_SS);
    float* XR = p.out;

    for (int rep = 0; rep < (EXP == 4 ? 2 : 1); ++rep) {
        LANE_INIT
        LAS float* scr = (LAS float*)(lds + wave * 16384);
        constexpr int I_IN = (D / 64) * (NIN / 32), I_SQ = (D / 64) * (D / 32), I_1 = (D / 64) * (FF / 32), I_2 = (FF / 64) * (D / 32);
        constexpr int NITEMS = I_IN + 3 * I_SQ + 2 * I_1 + 2 * I_2;
        for (int it = gw; it < NITEMS; it += NGW) {
            int r = it;
            if (r < I_IN) { transpose_item(p.w_in, D, NIN, WinT, scr, r, lane, p.mix_g); continue; } r -= I_IN;
            if (r < I_SQ) { transpose_item(p.w_out, D, D, WoT, scr, r, lane); continue; } r -= I_SQ;
            if (r < I_SQ) { transpose_item(p.pw_in, D, D, PinT, scr, r, lane, p.mix_g + D); continue; } r -= I_SQ;
            if (r < I_SQ) { transpose_item(p.pw_out, D, D, PoT, scr, r, lane); continue; } r -= I_SQ;
            if (r < 2 * I_1) { const int l = r / I_1; transpose_item(p.w1 + (size_t)l * D * FF, D, FF, W1T + (size_t)l * D * FF, scr, r % I_1, lane, p.mlp_g + (size_t)l * D); continue; } r -= 2 * I_1;
            { const int l = r / I_2; transpose_item(p.w2 + (size_t)l * D * FF, FF, D, W2T + (size_t)l * D * FF, scr, r % I_2, lane); }
        }
        for (int i = blockIdx.x * 512 + tid; i < 4 * 256 * 256 / 4; i += G * 512) {
            const f32x4 v = *((const f32x4*)p.pw_group + i); u32x2 w; w.x = cvt_pk_bf16(v.x, v.y); w.y = cvt_pk_bf16(v.z, v.w); *((u32x2*)WgB + i) = w; }
        for (int i = blockIdx.x * 512 + tid; i < 4 * M; i += G * 512) SS[M + i] = 0.f;
        for (int mrow = 2 * gw; mrow < M; mrow += 2 * NGW) {
            const f32x4* xr = (const f32x4*)(p.x + (size_t)mrow * D) + lane; u32x2* o8 = (u32x2*)(U + (size_t)mrow * D) + lane; float sq0 = 0.f, sq1 = 0.f;
            f32x4 v[8];
#pragma unroll
            for (int j = 0; j < 8; ++j) v[j] = xr[64 * j];
#pragma unroll
            for (int j = 0; j < 8; ++j) { const float q = (v[j].x * v[j].x + v[j].y * v[j].y) + (v[j].z * v[j].z + v[j].w * v[j].w); if (j < 4) sq0 += q; else sq1 += q;
                u32x2 w; w.x = cvt_pk_bf16(v[j].x, v[j].y); w.y = cvt_pk_bf16(v[j].z, v[j].w); o8[64 * j] = w; }
            sq0 = wave_sum(sq0); sq1 = wave_sum(sq1); if (lane == 0) { SS[mrow] = sq0; SS[mrow + 1] = sq1; }
        }
    }
    GSYNC();

    {
        { pg8::Gemm g{U, WinT, M, NQKVO, D, D, D, 0}; pg8::StaticOrder S; S.init(M, NQKVO, G, (int)blockIdx.x);
          pg8::EpiBf16<0> E{QKVO, NQKVO, 2, 0.125f, SS};
          pg8::gemm_phase(lds, g, S, E); }
        { pg8::Gemm g{PoT, WgB, D, D, 256, D, 256, 256}; pg8::StaticOrder S; S.init(D, D, G, (int)(G - 1 - blockIdx.x));
          pg8::EpiBf16<0> E{WcT, D, 0, 1.f, nullptr};
          pg8::gemm_phase(lds, g, S, E); }
        LANE_INIT
        const int fr = lane & 15, fq = lane >> 4, kh = wave >> 2;
        for (int rep = 0; rep < (EXP == 8 ? 2 : 1); ++rep)
        for (int jb = blockIdx.x; jb < M / 64; jb += G) {
            const int tok0 = jb * 64 + (wave & 3) * 16;
            const bf16_t* ap0 = WinT + (size_t)(NQKVO + fr) * D + 8 * fq + kh * 512; const bf16_t* ap1 = ap0 + 16 * D; const bf16_t* bp = U + (size_t)(tok0 + fr) * D + 8 * fq + kh * 512;
            f32x4 acc0 = (f32x4){0.f, 0.f, 0.f, 0.f}, acc1 = (f32x4){0.f, 0.f, 0.f, 0.f};
#pragma unroll 8
            for (int ks = 0; ks < 16; ++ks) {
                const bf16x8 a0 = *(const bf16x8*)(ap0 + 32 * ks), a1 = *(const bf16x8*)(ap1 + 32 * ks), bb = *(const bf16x8*)(bp + 32 * ks);
                acc0 = __builtin_amdgcn_mfma_f32_16x16x32_bf16(a0, bb, acc0, 0, 0, 0);
                acc1 = __builtin_amdgcn_mfma_f32_16x16x32_bf16(a1, bb, acc1, 0, 0, 0);
            }
            LAS f32x4* red = (LAS f32x4*)lds + ((wave & 3) * 64 + lane) * 2;
            if (kh == 1) { red[0] = acc0; red[1] = acc1; }
            __syncthreads();
            if (kh == 0) {
                acc0 += red[0]; acc1 += red[1];
                const float rr = 1.0f / sqrtf(SS[tok0 + fr] * (1.f / D) + EPS);
#pragma unroll
                for (int nt = 0; nt < 2; ++nt) {
                    const int n0 = 16 * nt + 4 * fq; const f32x4 bias = *(const f32x4*)(p.gate_b + n0);
                    f32x4 gv = (nt ? acc1 : acc0) * rr + bias;
                    const bool isf = ((n0 >> 3) & 1) != 0;
#pragma unroll
                    for (int e = 0; e < 4; ++e) { float t = SOFTCAP * tanhf(gv[e] * (1.0f / SOFTCAP)); if (isf) t = fminf(t, 0.f) - log1pf(expf(-fabsf(t))); gv[e] = t; }
                    *(f32x4*)(Gt + (size_t)(tok0 + fr) * 32 + n0) = gv;
                }
            }
            __syncthreads();
        }
    }
    GSYNC();

    { LANE_INIT mlstm_phase(lds, QKVO, Gt, HF, HB, tid, lane, wave); }
#if EXP == 1
    GSYNC(); { LANE_INIT mlstm_phase(lds, QKVO, Gt, HF, HB, tid, lane, wave); }
#endif
    GSYNC();

    { LANE_INIT
    for (int rep = 0; rep < (EXP == 6 ? 2 : 1); ++rep)
    for (int row = gw; row < M; row += NGW) {
#pragma unroll
        for (int jj = 0; jj < 4; ++jj) {
            const int c = 4 * lane + 256 * jj;
            const f32x4 hf = *(const f32x4*)(HF + (size_t)row * D + c), hb = *(const f32x4*)(HB + (size_t)row * D + c);
            const f32x4 hh = hf + hb;
            float ss = (hh.x * hh.x + hh.y * hh.y) + (hh.z * hh.z + hh.w * hh.w);
#pragma unroll
            for (int o = 1; o < 32; o <<= 1) ss += __shfl_xor(ss, o);
            const float r = 1.0f / sqrtf(ss * (1.f / DV) + EPS);
            const u32x2 ov = *(const u32x2*)(QKVO + (size_t)row * NQKVO + 2048 + c);
            const f32x4 hg = *(const f32x4*)(p.head_g + c);
            const float o0 = bf_lo(ov.x), o1 = bf_hi(ov.x), o2 = bf_lo(ov.y), o3 = bf_hi(ov.y);
            const float y0 = hh.x * r * hg.x / (1.f + __expf(-o0)), y1 = hh.y * r * hg.y / (1.f + __expf(-o1));
            const float y2 = hh.z * r * hg.z / (1.f + __expf(-o2)), y3 = hh.w * r * hg.w / (1.f + __expf(-o3));
            u32x2 w; w.x = cvt_pk_bf16(y0, y1); w.y = cvt_pk_bf16(y2, y3);
            *(u32x2*)(U + (size_t)row * D + c) = w;
        }
    } }
    GSYNC();

    {
        pg8::Gemm g{U, WoT, M, D, D, D, D, 0}; pg8::StaticOrder S; S.init(M, D, G, (int)blockIdx.x);
        pg8::EpiResF32 E{p.x, XR, D, nullptr, XB, SS + M};
        pg8::gemm_phase(lds, g, S, E);
#if EXP == 3
        pg8::EpiResF32 E2{p.x, (float*)(ws + WS_BIG), D, nullptr, (bf16_t*)(ws + WS_BIG + 64 * MiB), SS + 5 * M};
        pg8::gemm_phase(lds, g, S, E2);
#endif
    }
    GSYNC();

#define PHASE_PTRS unsigned char* wsp = p.ws; asm volatile("" : "+s"(wsp)); float* XRp = p.out; asm volatile("" : "+s"(XRp)); float* SSp = (float*)(wsp + WS_SS); (void)SSp; (void)XRp;
    for (int layer = 0; layer < 2; ++layer) {
        if (layer == 1) {
            {
                PHASE_PTRS
                pg8::Gemm g{(bf16_t*)(wsp + WS_XB), (bf16_t*)(wsp + WS_PIN), M, D, D, D, D, 0}; pg8::StaticOrder S; S.init(M, D, G, (int)blockIdx.x);
                pg8::EpiBf16<0> E{(bf16_t*)(wsp + WS_PA), D, 0, 1.f, SSp + 2 * M};
                pg8::gemm_phase(lds, g, S, E);
            }
            GSYNC();
            { LANE_INIT PHASE_PTRS
            for (int rep = 0; rep < (EXP == 7 ? 2 : 1); ++rep)
            for (int wt = gw; wt < 2048; wt += NGW) {
                const int rp = wt & 63, gidx = (wt >> 6) & 3, b = wt >> 8;
                const int t0 = (2 * rp + (lane >> 5)) * 16;
                const bf16_t* src = (const bf16_t*)(wsp + WS_PA) + (size_t)b * SEQ * D + gidx * 256 + 8 * (lane & 31);
                bf16_t* dst = (bf16_t*)(wsp + WS_PL) + (size_t)b * SEQ * D + gidx * 256 + 8 * (lane & 31);
                if (gidx == 0) pool_run<2, 16>(src, dst, t0); else if (gidx == 1) pool_run<4, 16>(src, dst, t0); else if (gidx == 2) pool_run<8, 16>(src, dst, t0); else { pool_run<16, 8>(src, dst, t0); pool_run<16, 8>(src, dst, t0 + 8); }
            } }
            GSYNC();
            {
                PHASE_PTRS
                pg8::Gemm g{(bf16_t*)(wsp + WS_PL), (bf16_t*)(wsp + WS_WCT), M, D, D, D, D, 0}; pg8::StaticOrder S; S.init(M, D, G, (int)blockIdx.x);
                pg8::EpiResF32 E{XRp, XRp, D, p.p_scale, (bf16_t*)(wsp + WS_XB), SSp + 3 * M};
                pg8::gemm_phase(lds, g, S, E);
            }
            GSYNC();
        }
        {
            PHASE_PTRS
            pg8::Gemm g{(bf16_t*)(wsp + WS_XB), (bf16_t*)(wsp + WS_W1) + (size_t)layer * D * FF, M, FF, D, D, D, 0}; pg8::StaticOrder S; S.init(M, FF, G, (int)blockIdx.x);
            pg8::EpiBf16<2> E{(bf16_t*)(wsp + WS_H1), FF, 0, 1.f, SSp + (size_t)(layer ? 3 : 1) * M};
            pg8::gemm_phase(lds, g, S, E);
#if EXP == 5
            pg8::gemm_phase(lds, g, S, E);
#endif
        }
        GSYNC();
        {
            PHASE_PTRS
            pg8::Gemm g{(bf16_t*)(wsp + WS_H1), (bf16_t*)(wsp + WS_W2) + (size_t)layer * D * FF, M, D, FF, FF, FF, 0}; pg8::StaticOrder S; S.init(M, D, G, (int)blockIdx.x);
            pg8::EpiResF32 E{XRp, XRp, D, nullptr, layer ? nullptr : (bf16_t*)(wsp + WS_XB), SSp + (size_t)(layer ? 4 : 2) * M};
            pg8::gemm_phase(lds, g, S, E);
        }
        GSYNC();
    }
    { LANE_INIT
      for (int mrow = gw; mrow < M; mrow += NGW) {
          const float r = 1.0f / sqrtf(SS[4 * M + mrow] * (1.f / D) + EPS);
          f32x4* xr = (f32x4*)(p.out + (size_t)mrow * D) + lane; const f32x4* gr = (const f32x4*)p.fin_g + lane;
#pragma unroll
          for (int j = 0; j < 4; ++j) xr[64 * j] = xr[64 * j] * r * gr[64 * j];
      } }
}

extern "C" void kernel_launch(void* const* d_in, const int* in_sizes, int n_in, void* d_out, int out_size, void* d_ws, size_t ws_size, hipStream_t stream) {
    static int grid_blocks = 0;
    if (grid_blocks == 0) {
        int dev = 0, cus = 0, per_cu = 0;
        hipGetDevice(&dev);
        hipDeviceGetAttribute(&cus, hipDeviceAttributeMultiprocessorCount, dev);
        hipFuncSetAttribute((const void*)fwd_kernel, hipFuncAttributeMaxDynamicSharedMemorySize, LDS_BYTES);
        hipOccupancyMaxActiveBlocksPerMultiprocessor(&per_cu, (const void*)fwd_kernel, 512, LDS_BYTES);
        if (per_cu < 1) per_cu = 1;
        if (per_cu > 1) per_cu = 1;
        grid_blocks = cus * per_cu;
        if (ws_size < WS_END) { fprintf(stderr, "kernel_launch: workspace too small (%zu < %zu)\n", ws_size, (size_t)WS_END); grid_blocks = -1; }
    }
    if (grid_blocks < 0) return;
    Params p{};
    p.x = (const float*)d_in[0]; p.mix_g = (const float*)d_in[1]; p.mlp_g = (const float*)d_in[2]; p.w_in = (const float*)d_in[3]; p.gate_b = (const float*)d_in[4];
    p.head_g = (const float*)d_in[5]; p.w_out = (const float*)d_in[6]; p.pw_in = (const float*)d_in[7]; p.pw_group = (const float*)d_in[8]; p.pw_out = (const float*)d_in[9];
    p.p_scale = (const float*)d_in[10]; p.w1 = (const float*)d_in[11]; p.w2 = (const float*)d_in[12]; p.fin_g = (const float*)d_in[13];
    p.out = (float*)d_out; p.ws = (unsigned char*)d_ws;
    if (hipMemsetAsync(d_ws, 0, 65536, stream) != hipSuccess) { fprintf(stderr, "kernel_launch: memset of the barrier words failed\n"); return; }
    void* args[] = {&p};
    hipError_t e = hipLaunchCooperativeKernel((const void*)fwd_kernel, dim3(grid_blocks), dim3(512), args, LDS_BYTES, stream);
    if (e != hipSuccess) fprintf(stderr, "cooperative launch failed: %s (grid %d)\n", hipGetErrorString(e), grid_blocks);
}
```

```cpp
#include <hip/hip_runtime.h>
#include <hip/hip_cooperative_groups.h>
#include <cstdio>
#include <cstdint>
namespace cg = cooperative_groups;
#ifndef EXP
#define EXP 0
#endif

#define LAS __attribute__((address_space(3)))
typedef unsigned short bf16_t;
typedef short bf16x8 __attribute__((ext_vector_type(8)));
typedef float f32x4 __attribute__((ext_vector_type(4)));
typedef unsigned u32x4 __attribute__((ext_vector_type(4)));
typedef unsigned u32x2 __attribute__((ext_vector_type(2)));

constexpr int D = 1024, BATCH = 8, SEQ = 2048, M = BATCH * SEQ, NH = 8, DK = 64, DV = 128, FF = 4096;
constexpr int NIN = 3104, NQKVO = 3072;
constexpr float EPS = 1e-6f, SOFTCAP = 15.0f;

constexpr size_t MiB = 1u << 20;
constexpr size_t WS_WIN = 2 * MiB, WS_WO = 9 * MiB, WS_PIN = 11 * MiB, WS_WG = 13 * MiB, WS_PO = 14 * MiB;
constexpr size_t WS_W1 = 16 * MiB  , WS_W2 = 32 * MiB  ;
constexpr size_t WS_U = 48 * MiB;
constexpr size_t WS_BIG = 80 * MiB;
constexpr size_t WS_QKVO = WS_BIG;
constexpr size_t WS_G = WS_BIG + 96 * MiB;
constexpr size_t WS_HB = WS_BIG + 98 * MiB;
constexpr size_t WS_H1 = WS_BIG;
constexpr size_t WS_PA = WS_BIG, WS_PL = WS_BIG + 32 * MiB, WS_MX = WS_BIG + 64 * MiB;
constexpr size_t WS_XB = WS_BIG + 128 * MiB;
constexpr size_t WS_WC = WS_PIN - 0;
constexpr size_t WS_WGB = WS_WG;
constexpr size_t WS_WCT = 242 * MiB;
constexpr size_t WS_SS = 65536;
constexpr size_t WS_END = 244 * MiB;

__device__ __forceinline__ unsigned cvt_pk_bf16(float lo, float hi) { unsigned r; asm("v_cvt_pk_bf16_f32 %0, %1, %2" : "=v"(r) : "v"(lo), "v"(hi)); return r; }
__device__ __forceinline__ float bf_lo(unsigned u) { return __uint_as_float(u << 16); }
__device__ __forceinline__ float bf_hi(unsigned u) { return __uint_as_float(u & 0xffff0000u); }

namespace pg8 {
constexpr int BM = 256, BK = 64, HALF = 128, HTB = HALF * BK * 2, STAGE_BYTES = 8 * HTB, NXCD = 8, WGM = 8;
__host__ __device__ __forceinline__ int lds_byte(int r, int c) { const int st = (r >> 4) * 2 + (c >> 5), rr = r & 15, cc = c & 31, ob = rr * 64 + cc * 2; return st * 1024 + (ob ^ (((ob >> 9) & 1) << 5)); }
__host__ __device__ __forceinline__ void stage_rc(int b, int& R, int& C) { const int st = b / 1024, sb = b % 1024, swz = sb ^ (((sb >> 9) & 1) << 5); R = (st >> 1) * 16 + swz / 64; C = (st & 1) * 32 + (swz % 64) / 2; }
__host__ __device__ __forceinline__ int perm32(int rho) { const int n = rho >> 4, i = rho & 15; return 8 * (i >> 2) + 4 * n + (i & 3); }

struct Unit { int pm, pn; };
struct Gemm { const bf16_t* A; const bf16_t* Bt; int M, N, K, lda, ldb, acol; };

struct StaticOrder {
    int nM, nN, nwg, G, c;
    __host__ __device__ void init(int M_, int N_, int G_, int c_) { nM = M_ / BM; nN = N_ / BM; nwg = nM * nN; G = G_; c = c_; }
    __host__ __device__ bool next(int i, Unit& u) const {
        const long L = (long)i * G + c; if (L >= nwg) return false;
        int wgid = (int)L; { const int q = nwg / NXCD, r = nwg % NXCD, xcd = wgid % NXCD, off = wgid / NXCD; wgid = (xcd < r ? xcd * (q + 1) : r * (q + 1) + (xcd - r) * q) + off; }
        const int nig = WGM * nN, gid = wgid / nig, fm = gid * WGM, gsz = (nM - fm) < WGM ? (nM - fm) : WGM;
        u.pm = fm + ((wgid % nig) % gsz); u.pn = (wgid % nig) / gsz; return true;
    }
};

template <int ACT  > struct EpiBf16 {
    static constexpr bool PERM = true;
    bf16_t* O; int ldc; int qtiles; float qscale;
    const float* ss;
    __device__ __forceinline__ void operator()(const f32x4 (&acc)[2][2][4][2], const Unit& u, int wr, int wc, int fr, int fq) const {
        const int row0 = u.pm * BM + wr * 64 + fr; const int col0 = u.pn * BM + wc * 32 + 8 * fq;
        const float sc0 = (u.pn < qtiles) ? qscale : 1.f;
#pragma unroll
        for (int ai = 0; ai < 2; ++ai)
#pragma unroll
            for (int m = 0; m < 4; ++m) { bf16_t* rowp = O + (size_t)(row0 + ai * HALF + m * 16) * ldc + col0;
                const float sc = ss ? sc0 / sqrtf(ss[row0 + ai * HALF + m * 16] * (1.f / 1024.f) + 1e-6f) : sc0;
#pragma unroll
                for (int bj = 0; bj < 2; ++bj) { f32x4 v0 = acc[ai][bj][m][0] * sc, v1 = acc[ai][bj][m][1] * sc;
                    if (ACT == 2) {
#pragma unroll
                        for (int e = 0; e < 4; ++e) { float a = fmaxf(v0[e], 0.f); v0[e] = a * a; float b = fmaxf(v1[e], 0.f); v1[e] = b * b; } }
                    u32x4 w; w.x = cvt_pk_bf16(v0[0], v0[1]); w.y = cvt_pk_bf16(v0[2], v0[3]); w.z = cvt_pk_bf16(v1[0], v1[1]); w.w = cvt_pk_bf16(v1[2], v1[3]);
                    *(u32x4*)(rowp + bj * HALF) = w; } }
    }
};
struct EpiResF32 {
    static constexpr bool PERM = false;
    const float* base; float* out; int ldc; const float* cscale;
    bf16_t* xb; float* ss;
    __device__ __forceinline__ void operator()(const f32x4 (&acc)[2][2][4][2], const Unit& u, int wr, int wc, int fr, int fq) const {
        const int col0 = u.pn * BM + wc * 32 + 4 * fq;
        f32x4 cs[2][2];
#pragma unroll
        for (int bj = 0; bj < 2; ++bj)
#pragma unroll
            for (int n = 0; n < 2; ++n) cs[bj][n] = cscale ? *(const f32x4*)(cscale + col0 + bj * HALF + n * 16) : (f32x4){1.f, 1.f, 1.f, 1.f};
#pragma unroll
        for (int ai = 0; ai < 2; ++ai)
#pragma unroll
            for (int m = 0; m < 4; ++m) { const size_t off = (size_t)(u.pm * BM + ai * HALF + wr * 64 + m * 16 + fr) * ldc + col0; float q = 0.f;
#pragma unroll
                for (int bj = 0; bj < 2; ++bj)
#pragma unroll
                    for (int n = 0; n < 2; ++n) { const f32x4 bs = *(const f32x4*)(base + off + bj * HALF + n * 16); const f32x4 o = bs + acc[ai][bj][m][n] * cs[bj][n];
                        *(f32x4*)(out + off + bj * HALF + n * 16) = o;
                        if (xb) { u32x2 w; w.x = cvt_pk_bf16(o[0], o[1]); w.y = cvt_pk_bf16(o[2], o[3]); *(u32x2*)(xb + off + bj * HALF + n * 16) = w; }
                        q += (o[0] * o[0] + o[1] * o[1]) + (o[2] * o[2] + o[3] * o[3]); }
                if (ss) { q += __shfl_xor(q, 16); q += __shfl_xor(q, 32);
                    if (fq == 0) (void)__hip_atomic_fetch_add(ss + (u.pm * BM + ai * HALF + wr * 64 + m * 16 + fr), q, __ATOMIC_RELAXED, __HIP_MEMORY_SCOPE_AGENT); } }
    }
};

template <class Epi>
__device__ __forceinline__ void gemm_phase(LAS unsigned char* lds, const Gemm g, const StaticOrder& S, const Epi& E) {
    int tid_ = threadIdx.x; asm volatile("" : "+v"(tid_));
    const int tid = tid_, wid = __builtin_amdgcn_readfirstlane(tid >> 6), lane = tid & 63, wr = wid >> 2, wc = wid & 3, fr = lane & 15, fq = lane >> 4;
    const int nt = g.K / BK;
    unsigned voffA[2], voffB[2];
#pragma unroll
    for (int i = 0; i < 2; ++i) { int R, C; stage_rc(tid * 16 + i * 8192, R, C); const int Rb = Epi::PERM ? ((R & ~31) + perm32(R & 31)) : R;
        voffA[i] = (unsigned)(R * g.lda + C) * 2u; voffB[i] = (unsigned)(Rb * g.ldb + C) * 2u; }
    const size_t kstep = (size_t)(BK * 2);
    const size_t hstepA = (size_t)HALF * g.lda * 2, hstepB = (size_t)HALF * g.ldb * 2;
    const size_t tstepA = 2 * hstepA, tstepB = 2 * hstepB;
    const unsigned ldsw = (unsigned)wid * 1024u;
    const int aoff = lds_byte(wr * 64 + fr, fq * 8), boff = lds_byte(wc * 32 + fr, fq * 8);
#define PG8_SA(b, h) (((b) * 2 + (h)) * HTB)
#define PG8_SB(b, h) ((4 + (b) * 2 + (h)) * HTB)
#define PG8_STAGE(bufoff, gbase, voff) do { _Pragma("unroll") for (int _i = 0; _i < 2; ++_i) \
        __builtin_amdgcn_global_load_lds((const unsigned*)((const char*)(gbase) + (voff)[_i]), (LAS unsigned*)(lds + (bufoff) + ldsw + _i * 8192), 16, 0, 0); } while (0)
#define PG8_LDA(dst, b, h) do { _Pragma("unroll") for (int m = 0; m < 4; ++m) _Pragma("unroll") for (int k = 0; k < 2; ++k) dst[m][k] = *(const LAS bf16x8*)(lds + PG8_SA(b, h) + aoff + m * 2048 + k * 1024); } while (0)
#define PG8_LDB(dst, b, h) do { _Pragma("unroll") for (int n = 0; n < 2; ++n) _Pragma("unroll") for (int k = 0; k < 2; ++k) dst[n][k] = *(const LAS bf16x8*)(lds + PG8_SB(b, h) + boff + n * 2048 + k * 1024); } while (0)
#define PG8_MMA(ai, bj, At, Bt) do { __builtin_amdgcn_s_setprio(1); _Pragma("unroll") for (int m = 0; m < 4; ++m) _Pragma("unroll") for (int n = 0; n < 2; ++n) _Pragma("unroll") for (int k = 0; k < 2; ++k) \
        acc[ai][bj][m][n] = __builtin_amdgcn_mfma_f32_16x16x32_bf16(Bt[n][k], At[m][k], acc[ai][bj][m][n], 0, 0, 0); __builtin_amdgcn_s_setprio(0); } while (0)
#define PG8_WAIT_V(n) asm volatile("s_waitcnt vmcnt(" #n ")" ::: "memory")
#define PG8_WAIT_L(n) asm volatile("s_waitcnt lgkmcnt(" #n ")" ::: "memory")
#define PG8_BAR __builtin_amdgcn_s_barrier()
#define PG8_SCHED __builtin_amdgcn_sched_barrier(0)
    Unit cur, nxt; int ui = 0;
    if (!S.next(0, cur)) return;
    f32x4 acc[2][2][4][2];
#pragma unroll
    for (int a = 0; a < 2; ++a)
#pragma unroll
        for (int b = 0; b < 2; ++b)
#pragma unroll
            for (int m = 0; m < 4; ++m)
#pragma unroll
                for (int n = 0; n < 2; ++n) acc[a][b][m][n] = (f32x4){0.f, 0.f, 0.f, 0.f};
    bf16x8 At[4][2], B0[2][2], B1[2][2];
    const char* cA = (const char*)g.A + (size_t)cur.pm * tstepA + (size_t)cur.pn * g.acol * 2; const char* cB = (const char*)g.Bt + (size_t)cur.pn * tstepB;
    PG8_STAGE(PG8_SB(0, 0), cB, voffB); PG8_STAGE(PG8_SB(0, 1), cB + hstepB, voffB); PG8_STAGE(PG8_SA(0, 0), cA, voffA); PG8_STAGE(PG8_SA(0, 1), cA + hstepA, voffA);
    if (wr == 1) PG8_BAR;
    PG8_WAIT_V(2); PG8_BAR;
    PG8_STAGE(PG8_SB(1, 0), cB + kstep, voffB); PG8_STAGE(PG8_SA(1, 0), cA + kstep, voffA); PG8_STAGE(PG8_SB(1, 1), cB + hstepB + kstep, voffB);
    PG8_WAIT_V(6); PG8_BAR;
    for (;;) {
        const bool has_next = S.next(ui + 1, nxt);
        const char* nA = has_next ? (const char*)g.A + (size_t)nxt.pm * tstepA + (size_t)nxt.pn * g.acol * 2 : cA; const char* nB = has_next ? (const char*)g.Bt + (size_t)nxt.pn * tstepB : cB;
        for (int t = 0; t < nt; t += 2) {
            const bool last = (t == nt - 2);
            const char* a1 = cA + (size_t)(t + 1) * kstep;
            const char* a2 = last ? nA : cA + (size_t)(t + 2) * kstep; const char* b2 = last ? nB : cB + (size_t)(t + 2) * kstep;
            const char* a3 = a2 + kstep; const char* b3 = b2 + kstep;
            PG8_LDB(B0, 0, 0); PG8_LDB(B1, 0, 1); PG8_SCHED; PG8_LDA(At, 0, 0); PG8_STAGE(PG8_SA(1, 1), a1 + hstepA, voffA);
            PG8_WAIT_V(8); PG8_WAIT_L(0); PG8_BAR; PG8_MMA(0, 0, At, B0); PG8_MMA(0, 1, At, B1); PG8_BAR; PG8_SCHED;
            PG8_LDA(At, 0, 1); PG8_STAGE(PG8_SB(0, 0), b2, voffB); PG8_STAGE(PG8_SB(0, 1), b2 + hstepB, voffB); PG8_STAGE(PG8_SA(0, 0), a2, voffA);
            PG8_WAIT_V(8); PG8_WAIT_L(0); PG8_BAR; PG8_MMA(1, 0, At, B0); PG8_MMA(1, 1, At, B1); PG8_BAR; PG8_SCHED;
            PG8_LDB(B0, 1, 0); PG8_LDB(B1, 1, 1); PG8_SCHED; PG8_LDA(At, 1, 0); PG8_STAGE(PG8_SA(0, 1), a2 + hstepA, voffA);
            PG8_WAIT_V(8); PG8_WAIT_L(0); PG8_BAR; PG8_MMA(0, 0, At, B0); PG8_MMA(0, 1, At, B1); PG8_BAR; PG8_SCHED;
            PG8_LDA(At, 1, 1); PG8_STAGE(PG8_SB(1, 0), b3, voffB); PG8_STAGE(PG8_SB(1, 1), b3 + hstepB, voffB); PG8_STAGE(PG8_SA(1, 0), a3, voffA);
            PG8_WAIT_V(8); PG8_WAIT_L(0); PG8_BAR; PG8_MMA(1, 0, At, B0); PG8_MMA(1, 1, At, B1); PG8_BAR; PG8_SCHED;
        }
        if (wr == 0) PG8_BAR;
        E(acc, cur, wr, wc, fr, fq);
        if (!has_next) break;
#pragma unroll
        for (int a = 0; a < 2; ++a)
#pragma unroll
            for (int b = 0; b < 2; ++b)
#pragma unroll
                for (int m = 0; m < 4; ++m)
#pragma unroll
                    for (int n = 0; n < 2; ++n) acc[a][b][m][n] = (f32x4){0.f, 0.f, 0.f, 0.f};
        cur = nxt; cA = nA; cB = nB; ++ui;
        if (wr == 1) PG8_BAR;
    }
    PG8_WAIT_V(0);
    PG8_BAR;
#undef PG8_SA
#undef PG8_SB
#undef PG8_STAGE
#undef PG8_LDA
#undef PG8_LDB
#undef PG8_MMA
#undef PG8_WAIT_V
#undef PG8_WAIT_L
#undef PG8_BAR
#undef PG8_SCHED
}
}


#define XB_TMO      128
#define XB_XCNT(j)  (256  + 64 * (j))
#define XB_XSUB(j)  (1280 + 64 * (j))
#define XB_XGEN(j)  (2304 + 64 * (j))
#define XB_TOP      3328
#define XB_TOPGEN   3392
#define XCD_BAR_WORDS 3456
#define XB_SPIN_CAP (1u << 18)
__device__ __forceinline__ unsigned xb_ld(unsigned* p)              { return __hip_atomic_load(p, __ATOMIC_RELAXED, __HIP_MEMORY_SCOPE_AGENT); }
__device__ __forceinline__ unsigned xb_add(unsigned* p, unsigned v) { return __hip_atomic_fetch_add(p, v, __ATOMIC_RELAXED, __HIP_MEMORY_SCOPE_AGENT); }
__device__ __forceinline__ unsigned xb_xcc_id() { return (unsigned)__builtin_amdgcn_s_getreg((3 << 11) | 20) & 0xFu; }
#define XB_SPIN(cond, bar) do { unsigned _sp = 0; while (cond) { __builtin_amdgcn_s_sleep(1); \
    if ((++_sp & 255u) == 0u) { if (xb_ld(&(bar)[XB_TMO])) break; if (_sp > XB_SPIN_CAP) { atomicAdd(&(bar)[XB_TMO], 1u); break; } } } } while (0)
struct XcdBarrier { unsigned* bar; unsigned x; volatile LAS unsigned* st; };
__device__ __forceinline__ XcdBarrier xcd_barrier_post(unsigned* bar, volatile LAS unsigned* st) {
    XcdBarrier b; b.bar = bar; b.x = xb_xcc_id(); b.st = st;
    if (threadIdx.x == 0) (void)xb_add(&bar[XB_XCNT(b.x)], 1u);
    return b;
}
__device__ __forceinline__ void xcd_barrier_complete(unsigned* bar, unsigned x, unsigned& nloc, unsigned& nx) {
    const unsigned G = gridDim.x * gridDim.y * gridDim.z;
    unsigned sum, cnt, mine, sp = 0u;
    for (;;) {
        sum = 0u; cnt = 0u; mine = 0u;
#pragma unroll
        for (unsigned j = 0; j < 16; ++j) { const unsigned c = xb_ld(&bar[XB_XCNT(j)]); sum += c; cnt += (c > 0u) ? 1u : 0u; mine = (j == x) ? c : mine; }
        if (sum == G) break;
        __builtin_amdgcn_s_sleep(1);
        if ((++sp & 255u) == 0u) { if (xb_ld(&bar[XB_TMO])) break; if (sp > XB_SPIN_CAP) { atomicAdd(&bar[XB_TMO], 1u); break; } }
    }
    nloc = mine > 0u ? mine : 1u; nx = cnt > 0u ? cnt : 1u;
}
__device__ __forceinline__ void xcd_barrier(unsigned* const bbar, volatile LAS unsigned* const bst) {
    asm volatile("s_waitcnt vmcnt(0)" ::: "memory");
    __syncthreads();
    if (threadIdx.x == 0) {
        unsigned* bar = bbar; const unsigned bx = xb_xcc_id();
        __builtin_amdgcn_s_waitcnt(0);
        unsigned nloc = bst[0], nx = bst[1];
        if (nloc == 0u) { xcd_barrier_complete(bar, bx, nloc, nx); bst[0] = nloc; bst[1] = nx; }
        const unsigned old = xb_add(&bar[XB_XSUB(bx)], 1u);
        const unsigned gen = old / nloc;
        if (old + 1u == (gen + 1u) * nloc) {
            __builtin_amdgcn_fence(__ATOMIC_RELEASE, "agent");
            asm volatile("s_waitcnt vmcnt(0)" ::: "memory");
            const unsigned og = xb_add(&bar[XB_TOP], 1u);
            const unsigned tg = og / nx;
            if (og + 1u == (tg + 1u) * nx) xb_add(&bar[XB_TOPGEN], 1u);
            else XB_SPIN(xb_ld(&bar[XB_TOPGEN]) == tg, bar);
            __builtin_amdgcn_fence(__ATOMIC_ACQUIRE, "agent");
            xb_add(&bar[XB_XGEN(bx)], 1u);
            asm volatile("s_waitcnt vmcnt(0)" ::: "memory");
        } else {
            XB_SPIN(xb_ld(&bar[XB_XGEN(bx)]) == gen, bar);
            __builtin_amdgcn_fence(__ATOMIC_ACQUIRE, "agent");
            asm volatile("s_waitcnt vmcnt(0)" ::: "memory");
        }
    }
    __syncthreads();
}

__device__ __forceinline__ float wave_sum(float v) {
#pragma unroll
    for (int o = 1; o < 64; o <<= 1) v += __shfl_xor(v, o);
    return v;
}
__device__ __forceinline__ float wave_incl_sum(float v, int lane) {
#pragma unroll
    for (int o = 1; o < 64; o <<= 1) { const float t = __shfl_up(v, o); if (lane >= o) v += t; }
    return v;
}
__device__ __forceinline__ float wave_incl_max(float v, int lane) {
#pragma unroll
    for (int o = 1; o < 64; o <<= 1) { const float t = __shfl_up(v, o); if (lane >= o) v = fmaxf(v, t); }
    return v;
}

__device__ __forceinline__ void transpose_item(const float* W, int K, int N, bf16_t* WT, LAS float* scr, int item, int lane, const float* kgain = nullptr) {
    const int nblk = N / 32, kb = item / nblk, nb = item % nblk, k0 = 64 * kb, n0 = 32 * nb;
#pragma unroll
    for (int i = 0; i < 32; ++i) { const int kk = 2 * i + (lane >> 5); const float gk = kgain ? kgain[k0 + kk] : 1.f; scr[kk * 33 + (lane & 31)] = W[(size_t)(k0 + kk) * N + n0 + (lane & 31)] * gk; }
    asm volatile("s_waitcnt lgkmcnt(0)" ::: "memory");
    const int c = lane & 7;
#pragma unroll
    for (int j = 0; j < 4; ++j) { const int n = (lane >> 3) + 8 * j; const LAS float* s = scr + (8 * c) * 33 + n;
        u32x4 o; o.x = cvt_pk_bf16(s[0 * 33], s[1 * 33]); o.y = cvt_pk_bf16(s[2 * 33], s[3 * 33]); o.z = cvt_pk_bf16(s[4 * 33], s[5 * 33]); o.w = cvt_pk_bf16(s[6 * 33], s[7 * 33]);
        *(u32x4*)(WT + (size_t)(n0 + n) * K + k0 + 8 * c) = o; }
    asm volatile("s_waitcnt lgkmcnt(0)" ::: "memory");
}

__device__ __forceinline__ void rms_row_bf16(const float* xrow, const float* g, bf16_t* orow, int lane) {
    const f32x4* xr = (const f32x4*)xrow + lane; const f32x4* gr = (const f32x4*)g + lane;
    f32x4 v[4]; float s = 0.f;
#pragma unroll
    for (int j = 0; j < 4; ++j) { v[j] = xr[64 * j]; s += (v[j].x * v[j].x + v[j].y * v[j].y) + (v[j].z * v[j].z + v[j].w * v[j].w); }
    const float r = 1.0f / sqrtf(wave_sum(s) * (1.f / D) + EPS);
    u32x2* o8 = (u32x2*)orow + lane;
#pragma unroll
    for (int j = 0; j < 4; ++j) { const f32x4 gg = gr[64 * j]; u32x2 w; w.x = cvt_pk_bf16(v[j].x * r * gg.x, v[j].y * r * gg.y); w.y = cvt_pk_bf16(v[j].z * r * gg.z, v[j].w * r * gg.w); o8[64 * j] = w; }
}
__device__ __forceinline__ void rms_row_f32(const float* xrow, const float* g, float* orow, int lane) {
    const f32x4* xr = (const f32x4*)xrow + lane; const f32x4* gr = (const f32x4*)g + lane;
    f32x4 v[4]; float s = 0.f;
#pragma unroll
    for (int j = 0; j < 4; ++j) { v[j] = xr[64 * j]; s += (v[j].x * v[j].x + v[j].y * v[j].y) + (v[j].z * v[j].z + v[j].w * v[j].w); }
    const float r = 1.0f / sqrtf(wave_sum(s) * (1.f / D) + EPS);
    f32x4* o = (f32x4*)orow + lane;
#pragma unroll
    for (int j = 0; j < 4; ++j) { const f32x4 gg = gr[64 * j]; o[64 * j] = v[j] * r * gg; }
}


template <int W, int T> __device__ __forceinline__ void pool_run(const bf16_t* src, bf16_t* dst, int t0) {
    constexpr int H = W / 2, NR = T + W - 1;
    u32x4 r[NR];
    const bf16_t* p0 = src + ((long)t0 - H) * D;
#pragma unroll
    for (int k = 0; k < NR; ++k) r[k] = *(const u32x4*)(p0 + (size_t)k * D);
#pragma unroll
    for (int k = 0; k < NR; ++k) { const int t = t0 - H + k; if (k < H || k >= T + H) { const bool ok = (t >= 0) && (t < SEQ); r[k] = ok ? r[k] : (u32x4){0u, 0u, 0u, 0u}; } }
    float s[8];
#pragma unroll
    for (int e = 0; e < 8; ++e) s[e] = 0.f;
#pragma unroll
    for (int k = 0; k < W; ++k) { s[0] += bf_lo(r[k].x); s[1] += bf_hi(r[k].x); s[2] += bf_lo(r[k].y); s[3] += bf_hi(r[k].y); s[4] += bf_lo(r[k].z); s[5] += bf_hi(r[k].z); s[6] += bf_lo(r[k].w); s[7] += bf_hi(r[k].w); }
#pragma unroll
    for (int i = 0; i < T; ++i) {
        const int t = t0 + i; const int lo = max(t - H, 0), hi = min(t + H, SEQ); const float ic = 1.0f / (float)(hi - lo);
        const u32x4 v = r[i + H]; u32x4 o;
        o.x = cvt_pk_bf16(s[0] * ic - bf_lo(v.x), s[1] * ic - bf_hi(v.x)); o.y = cvt_pk_bf16(s[2] * ic - bf_lo(v.y), s[3] * ic - bf_hi(v.y));
        o.z = cvt_pk_bf16(s[4] * ic - bf_lo(v.z), s[5] * ic - bf_hi(v.z)); o.w = cvt_pk_bf16(s[6] * ic - bf_lo(v.w), s[7] * ic - bf_hi(v.w));
        *(u32x4*)(dst + (size_t)t * D) = o;
        if (i + 1 < T) { const u32x4 a = r[i + W], d = r[i];
            s[0] += bf_lo(a.x) - bf_lo(d.x); s[1] += bf_hi(a.x) - bf_hi(d.x); s[2] += bf_lo(a.y) - bf_lo(d.y); s[3] += bf_hi(a.y) - bf_hi(d.y);
            s[4] += bf_lo(a.z) - bf_lo(d.z); s[5] += bf_hi(a.z) - bf_hi(d.z); s[6] += bf_lo(a.w) - bf_lo(d.w); s[7] += bf_hi(a.w) - bf_hi(d.w); }
    }
}

constexpr int LS = 72;
constexpr int ML_Q = 0, ML_K = 9216, ML_KWT = 18432, ML_VT = 27648, ML_CT = 39168, ML_BUFSZ = 50688, ML_TB = 2 * ML_BUFSZ, ML_END = ML_TB + 3 * SEQ * 4;
static_assert(ML_END <= 131072, "mLSTM LDS map");
#define ML_BAR() asm volatile("s_waitcnt lgkmcnt(0)\n\ts_barrier" ::: "memory")

__device__ __forceinline__ void mlstm_phase(LAS unsigned char* lds, const bf16_t* QKVO, const float* Gt, bf16_t* HF, bf16_t* HB, int tid, int lane, int wave) {
    const int fr = lane & 15, fq = lane >> 4, tt = wave & 3, vs = wave >> 2;
    LAS float* TBb = (LAS float*)(lds + ML_TB); LAS float* TBa = TBb + SEQ; LAS float* TBc = TBa + SEQ;
    const int nvt = vs ? 2 : 3, vt0 = vs ? 3 : 0;
    for (int item = blockIdx.x; item < 256; item += gridDim.x) {
        const int vh = item & 1, dir = (item >> 1) & 1, h = (item >> 2) & 7, b = item >> 5;
        const bf16_t* qb = QKVO + (size_t)b * SEQ * NQKVO + h * DK + 8 * wave;
        const bf16_t* kb = qb + 512;
        const bf16_t* vb = QKVO + (size_t)b * SEQ * NQKVO + 1024 + h * DV + vh * 64 + 8 * wave;
        const float* gi = Gt + (size_t)b * SEQ * 32 + (2 * dir) * 8 + h; const float* gf = gi + 8;
        bf16_t* Hout = (dir ? HB : HF) + (size_t)b * SEQ * D + h * DV + vh * 64;
        __syncthreads();
        {
            float liv[4], lfv[4];
#pragma unroll
            for (int c4 = 0; c4 < 4; ++c4) { const int pp = 64 * (wave + 8 * c4) + lane; const int pos = dir ? (SEQ - 1 - pp) : pp; liv[c4] = gi[(size_t)pos * 32]; lfv[c4] = gf[(size_t)pos * 32]; }
#pragma unroll
            for (int c4 = 0; c4 < 4; ++c4) { const int pp = 64 * (wave + 8 * c4) + lane;
                const float bcs = wave_incl_sum(lfv[c4], lane); const float a = liv[c4] - bcs; const float cm = wave_incl_max(a, lane);
                TBb[pp] = bcs; TBa[pp] = a; TBc[pp] = cm; }
        }
#pragma unroll
        for (int bufi = 0; bufi < 2; ++bufi) { LAS bf16_t* VTi = (LAS bf16_t*)(lds + bufi * ML_BUFSZ + ML_VT);
            for (int idx = tid; idx < 16 * 64; idx += 512) { const int r = 64 + (idx >> 6), c = idx & 63; VTi[r * LS + c] = (r == 64) ? (bf16_t)0x3F80 : (bf16_t)0; } }
        f32x4 accC[3];
#pragma unroll
        for (int i = 0; i < 3; ++i) accC[i] = (f32x4){0.f, 0.f, 0.f, 0.f};
        float m = 0.f;
        u32x4 q16, k16, v16;
        { const int pos = dir ? (SEQ - 1 - lane) : lane;
          q16 = *(const u32x4*)(qb + (size_t)pos * NQKVO); k16 = *(const u32x4*)(kb + (size_t)pos * NQKVO); v16 = *(const u32x4*)(vb + (size_t)pos * NQKVO); }
        __syncthreads();
#define ML_STAGE(jn, bufn, mcar) do { \
            LAS unsigned char* bb_ = lds + (bufn) * ML_BUFSZ; \
            LAS bf16_t* Qs_ = (LAS bf16_t*)(bb_ + ML_Q); LAS bf16_t* Ks_ = (LAS bf16_t*)(bb_ + ML_K); LAS bf16_t* KwT_ = (LAS bf16_t*)(bb_ + ML_KWT); LAS bf16_t* VT_ = (LAS bf16_t*)(bb_ + ML_VT); LAS bf16_t* CT_ = (LAS bf16_t*)(bb_ + ML_CT); \
            const float wk_ = __expf(TBa[64 * (jn) + lane] - fmaxf((mcar), TBc[64 * (jn) + 63])); \
            *(LAS u32x4*)(Qs_ + lane * LS + 8 * wave) = q16; \
            *(LAS u32x4*)(Ks_ + lane * LS + 8 * wave) = k16; \
            const unsigned kk_[4] = {k16.x, k16.y, k16.z, k16.w}, vv_[4] = {v16.x, v16.y, v16.z, v16.w}; \
            _Pragma("unroll") for (int e = 0; e < 4; ++e) { \
                const unsigned kw_ = cvt_pk_bf16(bf_lo(kk_[e]) * wk_, bf_hi(kk_[e]) * wk_); \
                KwT_[(8 * wave + 2 * e) * LS + lane] = (bf16_t)(kw_ & 0xffffu); KwT_[(8 * wave + 2 * e + 1) * LS + lane] = (bf16_t)(kw_ >> 16); \
                VT_[(8 * wave + 2 * e) * LS + lane] = (bf16_t)(vv_[e] & 0xffffu); VT_[(8 * wave + 2 * e + 1) * LS + lane] = (bf16_t)(vv_[e] >> 16); } \
            _Pragma("unroll") for (int vi = 0; vi < 3; ++vi) if (vi < nvt) { \
                u32x2 w_; w_.x = cvt_pk_bf16(accC[vi][0], accC[vi][1]); w_.y = cvt_pk_bf16(accC[vi][2], accC[vi][3]); \
                *(LAS u32x2*)(CT_ + (16 * (vt0 + vi) + fr) * LS + 16 * tt + 4 * fq) = w_; } \
        } while (0)
        ML_STAGE(0, 0, m);
        ML_BAR();
        for (int j = 0; j < SEQ / 64; ++j) {
            LAS unsigned char* bb = lds + (j & 1) * ML_BUFSZ;
            LAS bf16_t* Qs = (LAS bf16_t*)(bb + ML_Q); LAS bf16_t* Ks = (LAS bf16_t*)(bb + ML_K); LAS bf16_t* KwT = (LAS bf16_t*)(bb + ML_KWT);
            LAS bf16_t* VT = (LAS bf16_t*)(bb + ML_VT); LAS bf16_t* CT = (LAS bf16_t*)(bb + ML_CT);
            if (j + 1 < SEQ / 64) {
                const int pp = 64 * (j + 1) + lane; const int pn = dir ? (SEQ - 1 - pp) : pp;
                q16 = *(const u32x4*)(qb + (size_t)pn * NQKVO); k16 = *(const u32x4*)(kb + (size_t)pn * NQKVO); v16 = *(const u32x4*)(vb + (size_t)pn * NQKVO);
            }
            const int base = 64 * j;
            const float M63 = fmaxf(m, TBc[base + 63]), b_last = TBb[base + 63];
            const float decay = __expf(m - M63);
            const float Mt = fmaxf(m, TBc[base + 16 * tt + fr]), bt = TBb[base + 16 * tt + fr];
            bf16x8 qf[2];
            qf[0] = *(const LAS bf16x8*)(Qs + (16 * tt + fr) * LS + 8 * fq); qf[1] = *(const LAS bf16x8*)(Qs + (16 * tt + fr) * LS + 32 + 8 * fq);
            float p[4][4];
#pragma unroll
            for (int st = 0; st < 4; ++st) {
                if (st <= tt) {
                    f32x4 s4 = (f32x4){0.f, 0.f, 0.f, 0.f};
                    const bf16x8 kf0 = *(const LAS bf16x8*)(Ks + (16 * st + fr) * LS + 8 * fq), kf1 = *(const LAS bf16x8*)(Ks + (16 * st + fr) * LS + 32 + 8 * fq);
                    const f32x4 a4 = *(const LAS f32x4*)(TBa + base + 16 * st + 4 * fq);
                    s4 = __builtin_amdgcn_mfma_f32_16x16x32_bf16(kf0, qf[0], s4, 0, 0, 0);
                    s4 = __builtin_amdgcn_mfma_f32_16x16x32_bf16(kf1, qf[1], s4, 0, 0, 0);
#pragma unroll
                    for (int i = 0; i < 4; ++i) { const float w = (16 * st + 4 * fq + i <= 16 * tt + fr) ? __expf(a4[i] - Mt) : 0.f; p[st][i] = s4[i] * w; }
                } else {
#pragma unroll
                    for (int i = 0; i < 4; ++i) p[st][i] = 0.f;
                }
            }
            bf16x8 pb[2];
#pragma unroll
            for (int kk2 = 0; kk2 < 2; ++kk2) {
                u32x4 w; w.x = cvt_pk_bf16(p[2 * kk2][0], p[2 * kk2][1]); w.y = cvt_pk_bf16(p[2 * kk2][2], p[2 * kk2][3]);
                w.z = cvt_pk_bf16(p[2 * kk2 + 1][0], p[2 * kk2 + 1][1]); w.w = cvt_pk_bf16(p[2 * kk2 + 1][2], p[2 * kk2 + 1][3]);
                pb[kk2] = __builtin_bit_cast(bf16x8, w);
            }
            const float sc = __expf(m - Mt);
            f32x4 num[3];
#pragma unroll
            for (int vi = 0; vi < 3; ++vi) {
                const int vt = (vi < 2) ? (2 * vs + vi) : 4;
                f32x4 a1 = (f32x4){0.f, 0.f, 0.f, 0.f}, a2 = (f32x4){0.f, 0.f, 0.f, 0.f};
#pragma unroll
                for (int kk2 = 0; kk2 < 2; ++kk2) {
                    if (kk2 == 0 || tt >= 2) {
                        const u32x2 lo = *(const LAS u32x2*)(VT + (16 * vt + fr) * LS + 32 * kk2 + 4 * fq), hi = *(const LAS u32x2*)(VT + (16 * vt + fr) * LS + 32 * kk2 + 16 + 4 * fq);
                        const u32x4 vv = (u32x4){lo.x, lo.y, hi.x, hi.y};
                        a1 = __builtin_amdgcn_mfma_f32_16x16x32_bf16(__builtin_bit_cast(bf16x8, vv), pb[kk2], a1, 0, 0, 0);
                    }
                    const bf16x8 cf = *(const LAS bf16x8*)(CT + (16 * vt + fr) * LS + 32 * kk2 + 8 * fq);
                    a2 = __builtin_amdgcn_mfma_f32_16x16x32_bf16(cf, qf[kk2], a2, 0, 0, 0);
                }
                num[vi] = a1 + a2 * sc;
            }
            const float den = __shfl(num[2][0], fr);
            const float inv = 1.0f / fmaxf(fabsf(den), __expf(-(bt + Mt)));
            {
                const int tl = base + 16 * tt + fr; const int post = dir ? (SEQ - 1 - tl) : tl;
#pragma unroll
                for (int vi = 0; vi < 2; ++vi) { const f32x4 o = num[vi] * inv; u32x2 w; w.x = cvt_pk_bf16(o[0], o[1]); w.y = cvt_pk_bf16(o[2], o[3]);
                    *(u32x2*)(Hout + (size_t)post * D + 16 * (2 * vs + vi) + 4 * fq) = w; }
            }
            {
                const bf16x8 kf0 = *(const LAS bf16x8*)(KwT + (16 * tt + fr) * LS + 8 * fq), kf1 = *(const LAS bf16x8*)(KwT + (16 * tt + fr) * LS + 32 + 8 * fq);
#pragma unroll
                for (int vi = 0; vi < 3; ++vi) if (vi < nvt) {
                    const bf16x8 vf0 = *(const LAS bf16x8*)(VT + (16 * (vt0 + vi) + fr) * LS + 8 * fq), vf1 = *(const LAS bf16x8*)(VT + (16 * (vt0 + vi) + fr) * LS + 32 + 8 * fq);
                    f32x4 c = accC[vi] * decay;
                    c = __builtin_amdgcn_mfma_f32_16x16x32_bf16(kf0, vf0, c, 0, 0, 0);
                    c = __builtin_amdgcn_mfma_f32_16x16x32_bf16(kf1, vf1, c, 0, 0, 0);
                    accC[vi] = c; }
            }
            m = b_last + M63;
            if (j + 1 < SEQ / 64) ML_STAGE(j + 1, (j + 1) & 1, m);
            ML_BAR();
        }
#undef ML_STAGE
    }
}

struct Params {
    const float* x; const float* mix_g; const float* mlp_g; const float* w_in; const float* gate_b; const float* head_g; const float* w_out;
    const float* pw_in; const float* pw_group; const float* pw_out; const float* p_scale; const float* w1; const float* w2; const float* fin_g;
    float* out; unsigned char* ws;
};
constexpr int LDS_BYTES = 147456;

__global__ void __launch_bounds__(512, 2) fwd_kernel(Params p) {
    extern __shared__ __attribute__((aligned(16))) unsigned char lds_raw[];
    LAS unsigned char* lds = (LAS unsigned char*)lds_raw;
    cg::grid_group grid = cg::this_grid();
    if (p.ws == nullptr) grid.sync();
    volatile LAS unsigned* MISC = (volatile LAS unsigned*)(lds + 131072 + 320);
    if (threadIdx.x < 32) MISC[threadIdx.x] = 0u;
    __syncthreads();
    if (threadIdx.x == 0) (void)xb_add((unsigned*)p.ws + 4096 + XB_XCNT(xb_xcc_id()), 1u);
#if EXP == 2
#define GSYNC() do { xcd_barrier((unsigned*)p.ws + 4096, MISC + 8); xcd_barrier((unsigned*)p.ws + 4096, MISC + 8); } while (0)
#else
#define GSYNC() xcd_barrier((unsigned*)p.ws + 4096, MISC + 8)
#endif
    const int G = gridDim.x, NGW = G * 8;
#define LANE_INIT int tid = threadIdx.x; asm volatile("" : "+v"(tid)); const int lane = tid & 63, wave = __builtin_amdgcn_readfirstlane(tid >> 6), gw = blockIdx.x * 8 + wave; (void)gw; (void)lane;
    unsigned char* ws = p.ws;
    bf16_t* WinT = (bf16_t*)(ws + WS_WIN); bf16_t* WoT = (bf16_t*)(ws + WS_WO); bf16_t* PinT = (bf16_t*)(ws + WS_PIN); bf16_t* WgB = (bf16_t*)(ws + WS_WGB); bf16_t* PoT = (bf16_t*)(ws + WS_PO);
    bf16_t* WcT = (bf16_t*)(ws + WS_WCT); bf16_t* W1T = (bf16_t*)(ws + WS_W1); bf16_t* W2T = (bf16_t*)(ws + WS_W2);
    bf16_t* U = (bf16_t*)(ws + WS_U); bf16_t* XB = (bf16_t*)(ws + WS_XB); bf16_t* QKVO = (bf16_t*)(ws + WS_QKVO); float* Gt = (float*)(ws + WS_G); bf16_t* HF = (bf16_t*)(ws + WS_HB); bf16_t* HB = (bf16_t*)(ws + WS_HB + 32 * MiB);
    bf16_t* H1 = (bf16_t*)(ws + WS_H1); bf16_t* PA = (bf16_t*)(ws + WS_PA); bf16_t* PL = (bf16_t*)(ws + WS_PL);
    float* SS = (float*)(ws + WS_SS);
    float* XR = p.out;

    for (int rep = 0; rep < (EXP == 4 ? 2 : 1); ++rep) {
        LANE_INIT
        LAS float* scr = (LAS float*)(lds + wave * 16384);
        constexpr int I_IN = (D / 64) * (NIN / 32), I_SQ = (D / 64) * (D / 32), I_1 = (D / 64) * (FF / 32), I_2 = (FF / 64) * (D / 32);
        constexpr int NITEMS = I_IN + 3 * I_SQ + 2 * I_1 + 2 * I_2;
        for (int it = gw; it < NITEMS; it += NGW) {
            int r = it;
            if (r < I_IN) { transpose_item(p.w_in, D, NIN, WinT, scr, r, lane, p.mix_g); continue; } r -= I_IN;
            if (r < I_SQ) { transpose_item(p.w_out, D, D, WoT, scr, r, lane); continue; } r -= I_SQ;
            if (r < I_SQ) { transpose_item(p.pw_in, D, D, PinT, scr, r, lane, p.mix_g + D); continue; } r -= I_SQ;
            if (r < I_SQ) { transpose_item(p.pw_out, D, D, PoT, scr, r, lane); continue; } r -= I_SQ;
            if (r < 2 * I_1) { const int l = r / I_1; transpose_item(p.w1 + (size_t)l * D * FF, D, FF, W1T + (size_t)l * D * FF, scr, r % I_1, lane, p.mlp_g + (size_t)l * D); continue; } r -= 2 * I_1;
            { const int l = r / I_2; transpose_item(p.w2 + (size_t)l * D * FF, FF, D, W2T + (size_t)l * D * FF, scr, r % I_2, lane); }
        }
        for (int i = blockIdx.x * 512 + tid; i < 4 * 256 * 256 / 4; i += G * 512) {
            const f32x4 v = *((const f32x4*)p.pw_group + i); u32x2 w; w.x = cvt_pk_bf16(v.x, v.y); w.y = cvt_pk_bf16(v.z, v.w); *((u32x2*)WgB + i) = w; }
        for (int i = blockIdx.x * 512 + tid; i < 4 * M; i += G * 512) SS[M + i] = 0.f;
        for (int mrow = 2 * gw; mrow < M; mrow += 2 * NGW) {
            const f32x4* xr = (const f32x4*)(p.x + (size_t)mrow * D) + lane; u32x2* o8 = (u32x2*)(U + (size_t)mrow * D) + lane; float sq0 = 0.f, sq1 = 0.f;
            f32x4 v[8];
#pragma unroll
            for (int j = 0; j < 8; ++j) v[j] = xr[64 * j];
#pragma unroll
            for (int j = 0; j < 8; ++j) { const float q = (v[j].x * v[j].x + v[j].y * v[j].y) + (v[j].z * v[j].z + v[j].w * v[j].w); if (j < 4) sq0 += q; else sq1 += q;
                u32x2 w; w.x = cvt_pk_bf16(v[j].x, v[j].y); w.y = cvt_pk_bf16(v[j].z, v[j].w); o8[64 * j] = w; }
            sq0 = wave_sum(sq0); sq1 = wave_sum(sq1); if (lane == 0) { SS[mrow] = sq0; SS[mrow + 1] = sq1; }
        }
    }
    GSYNC();

    {
        { pg8::Gemm g{U, WinT, M, NQKVO, D, D, D, 0}; pg8::StaticOrder S; S.init(M, NQKVO, G, (int)blockIdx.x);
          pg8::EpiBf16<0> E{QKVO, NQKVO, 2, 0.125f, SS};
          pg8::gemm_phase(lds, g, S, E); }
        { pg8::Gemm g{PoT, WgB, D, D, 256, D, 256, 256}; pg8::StaticOrder S; S.init(D, D, G, (int)(G - 1 - blockIdx.x));
          pg8::EpiBf16<0> E{WcT, D, 0, 1.f, nullptr};
          pg8::gemm_phase(lds, g, S, E); }
        LANE_INIT
        const int fr = lane & 15, fq = lane >> 4, kh = wave >> 2;
        for (int rep = 0; rep < (EXP == 8 ? 2 : 1); ++rep)
        for (int jb = blockIdx.x; jb < M / 64; jb += G) {
            const int tok0 = jb * 64 + (wave & 3) * 16;
            const bf16_t* ap0 = WinT + (size_t)(NQKVO + fr) * D + 8 * fq + kh * 512; const bf16_t* ap1 = ap0 + 16 * D; const bf16_t* bp = U + (size_t)(tok0 + fr) * D + 8 * fq + kh * 512;
            f32x4 acc0 = (f32x4){0.f, 0.f, 0.f, 0.f}, acc1 = (f32x4){0.f, 0.f, 0.f, 0.f};
#pragma unroll 8
            for (int ks = 0; ks < 16; ++ks) {
                const bf16x8 a0 = *(const bf16x8*)(ap0 + 32 * ks), a1 = *(const bf16x8*)(ap1 + 32 * ks), bb = *(const bf16x8*)(bp + 32 * ks);
                acc0 = __builtin_amdgcn_mfma_f32_16x16x32_bf16(a0, bb, acc0, 0, 0, 0);
                acc1 = __builtin_amdgcn_mfma_f32_16x16x32_bf16(a1, bb, acc1, 0, 0, 0);
            }
            LAS f32x4* red = (LAS f32x4*)lds + ((wave & 3) * 64 + lane) * 2;
            if (kh == 1) { red[0] = acc0; red[1] = acc1; }
            __syncthreads();
            if (kh == 0) {
                acc0 += red[0]; acc1 += red[1];
                const float rr = 1.0f / sqrtf(SS[tok0 + fr] * (1.f / D) + EPS);
#pragma unroll
                for (int nt = 0; nt < 2; ++nt) {
                    const int n0 = 16 * nt + 4 * fq; const f32x4 bias = *(const f32x4*)(p.gate_b + n0);
                    f32x4 gv = (nt ? acc1 : acc0) * rr + bias;
                    const bool isf = ((n0 >> 3) & 1) != 0;
#pragma unroll
                    for (int e = 0; e < 4; ++e) { float t = SOFTCAP * tanhf(gv[e] * (1.0f / SOFTCAP)); if (isf) t = fminf(t, 0.f) - log1pf(expf(-fabsf(t))); gv[e] = t; }
                    *(f32x4*)(Gt + (size_t)(tok0 + fr) * 32 + n0) = gv;
                }
            }
            __syncthreads();
        }
    }
    GSYNC();

    { LANE_INIT mlstm_phase(lds, QKVO, Gt, HF, HB, tid, lane, wave); }
#if EXP == 1
    GSYNC(); { LANE_INIT mlstm_phase(lds, QKVO, Gt, HF, HB, tid, lane, wave); }
#endif
    GSYNC();

    { LANE_INIT
    for (int rep = 0; rep < (EXP == 6 ? 2 : 1); ++rep)
    for (int row = gw; row < M; row += NGW) {
#pragma unroll
        for (int jj = 0; jj < 4; ++jj) {
            const int c = 4 * lane + 256 * jj;
            const u32x2 hf = *(const u32x2*)(HF + (size_t)row * D + c), hb = *(const u32x2*)(HB + (size_t)row * D + c);
            const f32x4 hh = (f32x4){bf_lo(hf.x) + bf_lo(hb.x), bf_hi(hf.x) + bf_hi(hb.x), bf_lo(hf.y) + bf_lo(hb.y), bf_hi(hf.y) + bf_hi(hb.y)};
            float ss = (hh.x * hh.x + hh.y * hh.y) + (hh.z * hh.z + hh.w * hh.w);
#pragma unroll
            for (int o = 1; o < 32; o <<= 1) ss += __shfl_xor(ss, o);
            const float r = 1.0f / sqrtf(ss * (1.f / DV) + EPS);
            const u32x2 ov = *(const u32x2*)(QKVO + (size_t)row * NQKVO + 2048 + c);
            const f32x4 hg = *(const f32x4*)(p.head_g + c);
            const float o0 = bf_lo(ov.x), o1 = bf_hi(ov.x), o2 = bf_lo(ov.y), o3 = bf_hi(ov.y);
            const float y0 = hh.x * r * hg.x / (1.f + __expf(-o0)), y1 = hh.y * r * hg.y / (1.f + __expf(-o1));
            const float y2 = hh.z * r * hg.z / (1.f + __expf(-o2)), y3 = hh.w * r * hg.w / (1.f + __expf(-o3));
            u32x2 w; w.x = cvt_pk_bf16(y0, y1); w.y = cvt_pk_bf16(y2, y3);
            *(u32x2*)(U + (size_t)row * D + c) = w;
        }
    } }
    GSYNC();

    {
        pg8::Gemm g{U, WoT, M, D, D, D, D, 0}; pg8::StaticOrder S; S.init(M, D, G, (int)blockIdx.x);
        pg8::EpiResF32 E{p.x, XR, D, nullptr, XB, SS + M};
        pg8::gemm_phase(lds, g, S, E);
#if EXP == 3
        pg8::EpiResF32 E2{p.x, (float*)(ws + WS_BIG), D, nullptr, (bf16_t*)(ws + WS_BIG + 64 * MiB), SS + 5 * M};
        pg8::gemm_phase(lds, g, S, E2);
#endif
    }
    GSYNC();

#define PHASE_PTRS unsigned char* wsp = p.ws; asm volatile("" : "+s"(wsp)); float* XRp = p.out; asm volatile("" : "+s"(XRp)); float* SSp = (float*)(wsp + WS_SS); (void)SSp; (void)XRp;
    for (int layer = 0; layer < 2; ++layer) {
        if (layer == 1) {
            {
                PHASE_PTRS
                pg8::Gemm g{(bf16_t*)(wsp + WS_XB), (bf16_t*)(wsp + WS_PIN), M, D, D, D, D, 0}; pg8::StaticOrder S; S.init(M, D, G, (int)blockIdx.x);
                pg8::EpiBf16<0> E{(bf16_t*)(wsp + WS_PA), D, 0, 1.f, SSp + 2 * M};
                pg8::gemm_phase(lds, g, S, E);
            }
            GSYNC();
            { LANE_INIT PHASE_PTRS
            for (int rep = 0; rep < (EXP == 7 ? 2 : 1); ++rep)
            for (int wt = gw; wt < 2048; wt += NGW) {
                const int rp = wt & 63, gidx = (wt >> 6) & 3, b = wt >> 8;
                const int t0 = (2 * rp + (lane >> 5)) * 16;
                const bf16_t* src = (const bf16_t*)(wsp + WS_PA) + (size_t)b * SEQ * D + gidx * 256 + 8 * (lane & 31);
                bf16_t* dst = (bf16_t*)(wsp + WS_PL) + (size_t)b * SEQ * D + gidx * 256 + 8 * (lane & 31);
                if (gidx == 0) pool_run<2, 16>(src, dst, t0); else if (gidx == 1) pool_run<4, 16>(src, dst, t0); else if (gidx == 2) pool_run<8, 16>(src, dst, t0); else { pool_run<16, 8>(src, dst, t0); pool_run<16, 8>(src, dst, t0 + 8); }
            } }
            GSYNC();
            {
                PHASE_PTRS
                pg8::Gemm g{(bf16_t*)(wsp + WS_PL), (bf16_t*)(wsp + WS_WCT), M, D, D, D, D, 0}; pg8::StaticOrder S; S.init(M, D, G, (int)blockIdx.x);
                pg8::EpiResF32 E{XRp, XRp, D, p.p_scale, (bf16_t*)(wsp + WS_XB), SSp + 3 * M};
                pg8::gemm_phase(lds, g, S, E);
            }
            GSYNC();
        }
        {
            PHASE_PTRS
            pg8::Gemm g{(bf16_t*)(wsp + WS_XB), (bf16_t*)(wsp + WS_W1) + (size_t)layer * D * FF, M, FF, D, D, D, 0}; pg8::StaticOrder S; S.init(M, FF, G, (int)blockIdx.x);
            pg8::EpiBf16<2> E{(bf16_t*)(wsp + WS_H1), FF, 0, 1.f, SSp + (size_t)(layer ? 3 : 1) * M};
            pg8::gemm_phase(lds, g, S, E);
#if EXP == 5
            pg8::gemm_phase(lds, g, S, E);
#endif
        }
        GSYNC();
        {
            PHASE_PTRS
            pg8::Gemm g{(bf16_t*)(wsp + WS_H1), (bf16_t*)(wsp + WS_W2) + (size_t)layer * D * FF, M, D, FF, FF, FF, 0}; pg8::StaticOrder S; S.init(M, D, G, (int)blockIdx.x);
            pg8::EpiResF32 E{XRp, XRp, D, nullptr, layer ? nullptr : (bf16_t*)(wsp + WS_XB), SSp + (size_t)(layer ? 4 : 2) * M};
            pg8::gemm_phase(lds, g, S, E);
        }
        GSYNC();
    }
    { LANE_INIT
      for (int mrow = gw; mrow < M; mrow += NGW) {
          const float r = 1.0f / sqrtf(SS[4 * M + mrow] * (1.f / D) + EPS);
          f32x4* xr = (f32x4*)(p.out + (size_t)mrow * D) + lane; const f32x4* gr = (const f32x4*)p.fin_g + lane;
#pragma unroll
          for (int j = 0; j < 4; ++j) xr[64 * j] = xr[64 * j] * r * gr[64 * j];
      } }
}

extern "C" void kernel_launch(void* const* d_in, const int* in_sizes, int n_in, void* d_out, int out_size, void* d_ws, size_t ws_size, hipStream_t stream) {
    static int grid_blocks = 0;
    if (grid_blocks == 0) {
        int dev = 0, cus = 0, per_cu = 0;
        hipGetDevice(&dev);
        hipDeviceGetAttribute(&cus, hipDeviceAttributeMultiprocessorCount, dev);
        hipFuncSetAttribute((const void*)fwd_kernel, hipFuncAttributeMaxDynamicSharedMemorySize, LDS_BYTES);
        hipOccupancyMaxActiveBlocksPerMultiprocessor(&per_cu, (const void*)fwd_kernel, 512, LDS_BYTES);
        if (per_cu < 1) per_cu = 1;
        if (per_cu > 1) per_cu = 1;
        grid_blocks = cus * per_cu;
        if (ws_size < WS_END) { fprintf(stderr, "kernel_launch: workspace too small (%zu < %zu)\n", ws_size, (size_t)WS_END); grid_blocks = -1; }
    }
    if (grid_blocks < 0) return;
    Params p{};
    p.x = (const float*)d_in[0]; p.mix_g = (const float*)d_in[1]; p.mlp_g = (const float*)d_in[2]; p.w_in = (const float*)d_in[3]; p.gate_b = (const float*)d_in[4];
    p.head_g = (const float*)d_in[5]; p.w_out = (const float*)d_in[6]; p.pw_in = (const float*)d_in[7]; p.pw_group = (const float*)d_in[8]; p.pw_out = (const float*)d_in[9];
    p.p_scale = (const float*)d_in[10]; p.w1 = (const float*)d_in[11]; p.w2 = (const float*)d_in[12]; p.fin_g = (const float*)d_in[13];
    p.out = (float*)d_out; p.ws = (unsigned char*)d_ws;
    if (hipMemsetAsync(d_ws, 0, 65536, stream) != hipSuccess) { fprintf(stderr, "kernel_launch: memset of the barrier words failed\n"); return; }
    void* args[] = {&p};
    hipError_t e = hipLaunchCooperativeKernel((const void*)fwd_kernel, dim3(grid_blocks), dim3(512), args, LDS_BYTES, stream);
    if (e != hipSuccess) fprintf(stderr, "cooperative launch failed: %s (grid %d)\n", hipGetErrorString(e), grid_blocks);
}
```
